# Optimizing an MI355X kernel written in HIP

```python
import math
import jax, jax.numpy as jnp
from jax import lax
import numpy as np

D_MODEL = 4096
BATCH = 16
SEQ = 256
DEPTH = 2
DEC_BATCH = 2
DEC_SEQ = 2048
PAST_LEN = 512

GRID_W = 64
HEAD_DIM = 128
W_GROUP = D_MODEL // 4
W_LRU = W_GROUP
H_LRU = W_GROUP // HEAD_DIM
BW_LRU = W_LRU // H_LRU
CONV_W = 4
LRU_C = 8.0
H_GLA = W_GROUP // HEAD_DIM
DV_GLA = HEAD_DIM
DK_GLA = HEAD_DIM // 2
W_GLA = H_GLA * DV_GLA
GLA_RANK = 16
GLA_TAU = 16.0
GLA_CHUNK = 64
H_SWA = W_GROUP // HEAD_DIM
KV_SWA = 2
WINDOW = 128
H_GLB = W_GROUP // HEAD_DIM
KV_GLB = 2
Q_BLOCK = 128
ROPE_THETA = 10000.0
D_MIX = W_LRU + W_GLA + H_SWA * HEAD_DIM + H_GLB * HEAD_DIM
IN_SPLITS = (W_LRU, W_LRU,
             H_GLA * DK_GLA, H_GLA * DK_GLA, W_GLA, 2 * GLA_RANK, W_GLA,
             H_SWA * HEAD_DIM, KV_SWA * HEAD_DIM, KV_SWA * HEAD_DIM, H_SWA * HEAD_DIM,
             H_GLB * HEAD_DIM, KV_GLB * HEAD_DIM, KV_GLB * HEAD_DIM, H_GLB * HEAD_DIM)
N_IN = 2 * W_LRU + 2 * H_GLA * DK_GLA + 2 * W_GLA + 2 * GLA_RANK + 2 * (2 * H_SWA + 2 * KV_SWA) * HEAD_DIM
EPS = 1e-6
NEG = -1e30

kernel_name = 'hymba_flow_prefix_lru_gla_swa_glb'

F32 = jnp.float32


def rmsnorm(x, w):
    xf = x.astype(F32)
    y = xf * lax.rsqrt(jnp.mean(xf * xf, axis=-1, keepdims=True) + EPS)
    return (y * w.astype(F32)).astype(x.dtype)


def split_cols(u):
    bounds = [int(b) for b in np.cumsum(IN_SPLITS)[:-1]]
    return jnp.split(u, bounds, axis=-1)


def rope_tables(T):
    rows = T // GRID_W
    r, col = jnp.meshgrid(jnp.arange(rows), jnp.arange(GRID_W), indexing='ij')
    pos = jnp.stack([r.reshape(-1), col.reshape(-1)], axis=-1).astype(F32)
    inv = ROPE_THETA ** (-jnp.arange(0, HEAD_DIM // 2, 2, dtype=F32) / (HEAD_DIM // 2))
    ang = pos[:, :, None, None] * inv
    ang = jnp.broadcast_to(ang, (T, 2, 2, HEAD_DIM // 4)).reshape(T, HEAD_DIM)
    return jnp.cos(ang), jnp.sin(ang)


def apply_rope(x, cos, sin):
    xf = x.astype(F32)
    xs = xf.reshape(xf.shape[:-1] + (2, 2, HEAD_DIM // 4))
    rot = jnp.concatenate([-xs[..., 1:, :], xs[..., :1, :]], axis=-2).reshape(xf.shape)
    return (xf * cos + rot * sin).astype(x.dtype)


def dwconv(x, w, b):
    C = x.shape[-1]
    y = lax.conv_general_dilated(x, w[:, None, :].astype(x.dtype), window_strides=(1,),
                                 padding=[(CONV_W // 2, CONV_W - 1 - CONV_W // 2)],
                                 dimension_numbers=('NWC', 'WIO', 'NWC'), feature_group_count=C)
    return y + b.astype(x.dtype)


def linear_scan(a, b, h0):
    b = b.at[:, 0].add(a[:, 0] * h0)
    def comb(l, r):
        return (l[0] * r[0], r[0] * l[1] + r[1])
    _, h = lax.associative_scan(comb, (a, b), axis=1)
    return h


def rglru_branch(xb, conv_w, conv_b, w_a, b_a, w_x, b_x, lam, h0):
    B, T, _ = xb.shape
    xc = dwconv(xb, conv_w, conv_b).astype(F32)
    xh = xc.reshape(B, T, H_LRU, BW_LRU)
    h0 = h0.astype(F32)
    outs, finals = [], []
    for d in range(2):
        r = jax.nn.sigmoid(jnp.einsum('bthi,hij->bthj', xh, w_a[d].astype(F32)).reshape(B, T, W_LRU) + b_a[d].astype(F32))
        i = jax.nn.sigmoid(jnp.einsum('bthi,hij->bthj', xh, w_x[d].astype(F32)).reshape(B, T, W_LRU) + b_x[d].astype(F32))
        log_a = -LRU_C * r * jax.nn.softplus(-lam[d].astype(F32))
        a = jnp.exp(log_a)
        inp = jnp.sqrt(-jnp.expm1(2.0 * log_a)) * (i * xc)
        if d == 1:
            a, inp = a[:, ::-1], inp[:, ::-1]
        h = linear_scan(a, inp, h0[:, d])
        finals.append(h[:, -1])
        outs.append(h if d == 0 else h[:, ::-1])
    return outs[0] + outs[1], jnp.stack(finals, axis=1)


def gla_chunked(q, k, v, log_a, S0):
    B, H, T, DK = q.shape
    DV = v.shape[-1]
    C = GLA_CHUNK
    N = T // C
    q = q.reshape(B, H, N, C, DK)
    k = k.reshape(B, H, N, C, DK)
    v = v.reshape(B, H, N, C, DV)
    bcum = jnp.cumsum(log_a.reshape(B, H, N, C, DK), axis=3)
    b_last = bcum[:, :, :, -1:, :]
    b_ref = bcum[:, :, :, C // 2:C // 2 + 1, :]
    kv = jnp.einsum('bhncd,bhnce->bhnde', k * jnp.exp(b_last - bcum), v)
    dec = jnp.exp(b_last[:, :, :, 0, :])
    def step(S, xs):
        dn, kvn = xs
        return dn[..., None] * S + kvn, S
    S_fin, S_start = lax.scan(step, S0.astype(F32), (jnp.moveaxis(dec, 2, 0), jnp.moveaxis(kv, 2, 0)))
    S_start = jnp.moveaxis(S_start, 0, 2)
    inter = jnp.einsum('bhncd,bhnde->bhnce', q * jnp.exp(bcum), S_start)
    A = jnp.einsum('bhnid,bhnjd->bhnij', q * jnp.exp(bcum - b_ref), k * jnp.exp(b_ref - bcum))
    A = jnp.where(jnp.tril(jnp.ones((C, C), dtype=bool)), A, 0.0)
    intra = jnp.einsum('bhnij,bhnje->bhnie', A, v)
    return (inter + intra).reshape(B, H, T, DV), S_fin


def gla_branch(gq, gk, gv, glr, w_up, b_up, g_norm, S0):
    B, T, _ = gq.shape
    q = gq.reshape(B, T, H_GLA, DK_GLA).transpose(0, 2, 1, 3).astype(F32) * (DK_GLA ** -0.5)
    k = gk.reshape(B, T, H_GLA, DK_GLA).transpose(0, 2, 1, 3).astype(F32)
    v = gv.reshape(B, T, H_GLA, DV_GLA).transpose(0, 2, 1, 3).astype(F32)
    lr = glr.reshape(B, T, 2, GLA_RANK).astype(F32)
    z = jnp.einsum('btdr,dre->dbte', lr, w_up.astype(F32)) + b_up.astype(F32)[:, None, None, :]
    log_a = (jax.nn.log_sigmoid(z) / GLA_TAU).reshape(2, B, T, H_GLA, DK_GLA).transpose(0, 1, 3, 2, 4)
    o_f, S_f = gla_chunked(q, k, v, log_a[0], S0[:, 0])
    o_b, S_b = gla_chunked(q[:, :, ::-1], k[:, :, ::-1], v[:, :, ::-1], log_a[1][:, :, ::-1], S0[:, 1])
    o = rmsnorm(o_f + o_b[:, :, ::-1], g_norm)
    return o.transpose(0, 2, 1, 3).reshape(B, T, W_GLA), jnp.stack([S_f, S_b], axis=1)


def to_q_heads(q, n_kv):
    B, T, _ = q.shape
    return q.reshape(B, T, n_kv, -1, HEAD_DIM).transpose(0, 2, 3, 1, 4)


def to_kv_heads(k):
    B, T, _ = k.shape
    return k.reshape(B, T, -1, HEAD_DIM).transpose(0, 2, 1, 3)


def from_q_heads(o):
    B, KV, G, T, HD = o.shape
    return o.transpose(0, 3, 1, 2, 4).reshape(B, T, KV * G * HD)


def dense_attn(q, k, v, sink):
    B, KV, G, T, HD = q.shape
    nb = T // Q_BLOCK
    qb = q.reshape(B, KV, G, nb, Q_BLOCK, HD).transpose(3, 0, 1, 2, 4, 5)
    scale = HEAD_DIM ** -0.5
    def one(qblk):
        s = jnp.einsum('bkgqd,bksd->bkgqs', qblk, k, preferred_element_type=F32) * scale
        if sink is not None:
            sk = jnp.broadcast_to(sink.astype(F32)[None, :, :, None, None], s.shape[:-1] + (1,))
            p = jax.nn.softmax(jnp.concatenate([s, sk], axis=-1), axis=-1)[..., :-1]
        else:
            p = jax.nn.softmax(s, axis=-1)
        return jnp.einsum('bkgqs,bksd->bkgqd', p.astype(v.dtype), v)
    o = lax.map(one, qb)
    return o.transpose(1, 2, 3, 0, 4, 5).reshape(B, KV, G, T, HD)


def swa_latent_attn(q, k, v, ck, cv, sink):
    B, KV, G, T, HD = q.shape
    nb = T // Q_BLOCK
    span = Q_BLOCK + 2 * WINDOW
    Lc = ck.shape[2]
    pad = ((0, 0), (0, 0), (WINDOW, WINDOW), (0, 0))
    kp, vp = jnp.pad(k, pad), jnp.pad(v, pad)
    idx = jnp.arange(nb)[:, None] * Q_BLOCK + jnp.arange(span)[None, :]
    kb, vb = kp[:, :, idx], vp[:, :, idx]
    qpos = jnp.arange(nb)[:, None] * Q_BLOCK + jnp.arange(Q_BLOCK)[None, :]
    kpos = (idx - WINDOW)[:, None, :]
    mask = (jnp.abs(qpos[:, :, None] - kpos) <= WINDOW) & (kpos >= 0) & (kpos < T)
    qb = q.reshape(B, KV, G, nb, Q_BLOCK, HD)
    scale = HEAD_DIM ** -0.5
    s_loc = jnp.einsum('bkgnqd,bknsd->bkgnqs', qb, kb, preferred_element_type=F32) * scale
    s_loc = jnp.where(mask, s_loc, NEG)
    s_ctx = jnp.einsum('bkgnqd,bkcd->bkgnqc', qb, ck, preferred_element_type=F32) * scale
    sk = jnp.broadcast_to(sink.astype(F32)[None, :, :, None, None, None], s_loc.shape[:-1] + (1,))
    p = jax.nn.softmax(jnp.concatenate([s_loc, s_ctx, sk], axis=-1), axis=-1)
    o = (jnp.einsum('bkgnqs,bknsd->bkgnqd', p[..., :span].astype(v.dtype), vb)
         + jnp.einsum('bkgnqc,bkcd->bkgnqd', p[..., span:span + Lc].astype(cv.dtype), cv))
    return o.reshape(B, KV, G, T, HD)


def modulation(cvec, w_mod, b_mod):
    m = jnp.matmul(jax.nn.silu(cvec), w_mod) + b_mod
    shift, scale, gate = jnp.split(m, 3, axis=-1)
    return shift[:, None, :], scale[:, None, :], gate[:, None, :]


def trunk_layer(x, shift, scale, gate, p, ctx, rope):
    B, T, _ = x.shape
    latent = ctx is not None
    h = rmsnorm(x, p['norm_w']) * (1.0 + scale) + shift
    u = jnp.matmul(h, p['w_in'])
    (lru_x, lru_g, gla_q, gla_k, gla_v, gla_lr, gla_g,
     swa_q, swa_k, swa_v, swa_g, glb_q, glb_k, glb_v, glb_g) = split_cols(u)
    h0 = ctx['lru'] if latent else jnp.zeros((B, 2, W_LRU), F32)
    o_lru, st_lru = rglru_branch(lru_x, p['lru_conv_w'], p['lru_conv_b'], p['lru_w_a'], p['lru_b_a'],
                                 p['lru_w_x'], p['lru_b_x'], p['lru_lambda'], h0)
    S0 = ctx['gla'] if latent else jnp.zeros((B, 2, H_GLA, DK_GLA, DV_GLA), F32)
    o_gla, st_gla = gla_branch(gla_q, gla_k, gla_v, gla_lr, p['gla_w_up'], p['gla_b_up'], p['gla_norm'], S0)
    sink = p['swa_sink'].reshape(KV_SWA, H_SWA // KV_SWA)
    qs, ks, vs = to_q_heads(swa_q, KV_SWA), to_kv_heads(swa_k), to_kv_heads(swa_v)
    qg = rmsnorm(to_q_heads(glb_q, KV_GLB), p['glb_q_norm'])
    kg = rmsnorm(to_kv_heads(glb_k), p['glb_k_norm'])
    vg = to_kv_heads(glb_v)
    if latent:
        cos, sin = rope
        o_swa = swa_latent_attn(apply_rope(qs, cos, sin), apply_rope(ks, cos, sin), vs,
                                ctx['swa_k'], ctx['swa_v'], sink)
        k_all = jnp.concatenate([ctx['glb_k'].astype(kg.dtype), apply_rope(kg, cos, sin)], axis=2)
        v_all = jnp.concatenate([ctx['glb_v'].astype(vg.dtype), vg], axis=2)
        o_glb = dense_attn(apply_rope(qg, cos, sin), k_all, v_all, None)
    else:
        o_swa = dense_attn(qs, ks, vs, sink)
        o_glb = dense_attn(qg, kg, vg, None)
    merged = jnp.concatenate([o_lru * jax.nn.silu(lru_g),
                              o_gla * jax.nn.silu(gla_g),
                              from_q_heads(o_swa) * jax.nn.silu(swa_g),
                              from_q_heads(o_glb) * jax.nn.silu(glb_g)], axis=-1).astype(x.dtype)
    x = x + gate * jnp.matmul(merged, p['w_out'])
    states = None if latent else (st_lru, st_gla, ks, vs, kg, vg)
    return x, states


def setup_inputs(seed: int = 0) -> dict:
    key = jax.random.key(seed)
    ks = jax.random.split(key, 32)
    nrm = lambda k, s, sc: jax.random.normal(k, s, F32) * sc
    G = jax.random.uniform(ks[20], (DEPTH, 2, W_LRU), F32, 0.9, 0.999) ** (1.0 / LRU_C)
    return {
        'x_prompt': nrm(ks[0], (BATCH, SEQ, D_MODEL), 1.0),
        'x_sample': nrm(ks[1], (DEC_BATCH, DEC_SEQ, D_MODEL), 1.0),
        'c': nrm(ks[2], (DEC_BATCH, D_MODEL), 1.0),
        'state_lru': nrm(ks[3], (DEC_BATCH, DEPTH, 2, W_LRU), 0.5),
        'state_gla': nrm(ks[4], (DEC_BATCH, DEPTH, 2, H_GLA, DK_GLA, DV_GLA), 1.0),
        'cache_swa_k': nrm(ks[5], (DEC_BATCH, DEPTH, KV_SWA, PAST_LEN, HEAD_DIM), 1.0),
        'cache_swa_v': nrm(ks[6], (DEC_BATCH, DEPTH, KV_SWA, PAST_LEN, HEAD_DIM), 1.0),
        'cache_glb_k': nrm(ks[7], (DEC_BATCH, DEPTH, KV_GLB, PAST_LEN, HEAD_DIM), 1.0),
        'cache_glb_v': nrm(ks[8], (DEC_BATCH, DEPTH, KV_GLB, PAST_LEN, HEAD_DIM), 1.0),
        'c_ctx': nrm(ks[9], (D_MODEL,), 1.0),
        'norm_w': 1.0 + nrm(ks[10], (DEPTH, D_MODEL), 0.02),
        'w_mod': nrm(ks[11], (DEPTH, D_MODEL, 3 * D_MODEL), D_MODEL ** -0.5),
        'b_mod': nrm(ks[12], (DEPTH, 3 * D_MODEL), 0.02),
        'w_in': nrm(ks[13], (DEPTH, D_MODEL, N_IN), D_MODEL ** -0.5),
        'lru_conv_w': nrm(ks[14], (DEPTH, CONV_W, W_LRU), CONV_W ** -0.5),
        'lru_conv_b': nrm(ks[15], (DEPTH, W_LRU), 0.02),
        'lru_w_a': nrm(ks[16], (DEPTH, 2, H_LRU, BW_LRU, BW_LRU), BW_LRU ** -0.5),
        'lru_b_a': nrm(ks[17], (DEPTH, 2, W_LRU), 0.02),
        'lru_w_x': nrm(ks[18], (DEPTH, 2, H_LRU, BW_LRU, BW_LRU), BW_LRU ** -0.5),
        'lru_b_x': nrm(ks[19], (DEPTH, 2, W_LRU), 0.02),
        'lru_lambda': jnp.log(G) - jnp.log1p(-G),
        'gla_w_up': nrm(ks[21], (DEPTH, 2, GLA_RANK, H_GLA * DK_GLA), GLA_RANK ** -0.5),
        'gla_b_up': nrm(ks[22], (DEPTH, 2, H_GLA * DK_GLA), 0.02),
        'gla_norm': 1.0 + nrm(ks[23], (DEPTH, DV_GLA), 0.02),
        'swa_sink': nrm(ks[24], (DEPTH, H_SWA), 1.0),
        'glb_q_norm': 1.0 + nrm(ks[25], (DEPTH, HEAD_DIM), 0.02),
        'glb_k_norm': 1.0 + nrm(ks[26], (DEPTH, HEAD_DIM), 0.02),
        'w_out': nrm(ks[27], (DEPTH, D_MIX, D_MODEL), D_MIX ** -0.5),
        'final_norm': 1.0 + nrm(ks[28], (D_MODEL,), 0.02),
    }


def reference(x_prompt, x_sample, c, state_lru, state_gla, cache_swa_k, cache_swa_v, cache_glb_k, cache_glb_v,
              c_ctx, norm_w, w_mod, b_mod, w_in, lru_conv_w, lru_conv_b, lru_w_a, lru_b_a, lru_w_x, lru_b_x,
              lru_lambda, gla_w_up, gla_b_up, gla_norm, swa_sink, glb_q_norm, glb_k_norm, w_out, final_norm):
    rope = rope_tables(x_sample.shape[1])
    xp, xs = x_prompt, x_sample
    n_lru, n_gla, n_sk, n_sv, n_gk, n_gv = [], [], [], [], [], []
    for l in range(DEPTH):
        p = dict(norm_w=norm_w[l], w_in=w_in[l], lru_conv_w=lru_conv_w[l], lru_conv_b=lru_conv_b[l],
                 lru_w_a=lru_w_a[l], lru_b_a=lru_b_a[l], lru_w_x=lru_w_x[l], lru_b_x=lru_b_x[l],
                 lru_lambda=lru_lambda[l], gla_w_up=gla_w_up[l], gla_b_up=gla_b_up[l], gla_norm=gla_norm[l],
                 swa_sink=swa_sink[l], glb_q_norm=glb_q_norm[l], glb_k_norm=glb_k_norm[l], w_out=w_out[l])
        sh, sc, gt = modulation(c_ctx[None, :], w_mod[l], b_mod[l])
        xp, st = trunk_layer(xp, sh, sc, gt, p, None, None)
        n_lru.append(st[0]); n_gla.append(st[1]); n_sk.append(st[2]); n_sv.append(st[3])
        n_gk.append(st[4]); n_gv.append(st[5])
        sh, sc, gt = modulation(c, w_mod[l], b_mod[l])
        ctx = dict(lru=state_lru[:, l], gla=state_gla[:, l], swa_k=cache_swa_k[:, l], swa_v=cache_swa_v[:, l],
                   glb_k=cache_glb_k[:, l], glb_v=cache_glb_v[:, l])
        xs, _ = trunk_layer(xs, sh, sc, gt, p, ctx, rope)
    y_prompt = rmsnorm(xp, final_norm)
    y_sample = rmsnorm(xs, final_norm)
    return (y_prompt, y_sample, jnp.stack(n_lru, axis=1), jnp.stack(n_gla, axis=1),
            jnp.stack(n_sk, axis=1), jnp.stack(n_sv, axis=1), jnp.stack(n_gk, axis=1), jnp.stack(n_gv, axis=1))
```

```cpp
#include <hip/hip_runtime.h>
#include <hip/hip_bf16.h>
#include <hip/hip_cooperative_groups.h>
#include <cstdio>
namespace cg = cooperative_groups;

#ifndef MULTI_LAUNCH
#define MULTI_LAUNCH 0
#endif

typedef unsigned short bfu;
using bf16 = __hip_bfloat16;
using bf16x8 = __attribute__((ext_vector_type(8))) short;
using s16x4 = __attribute__((ext_vector_type(4))) short;
using f32x4 = __attribute__((ext_vector_type(4))) float;
using f32x16 = __attribute__((ext_vector_type(16))) float;
using u32x4 = __attribute__((ext_vector_type(4))) unsigned;

constexpr int DM = 4096, NTOK = 8192, NU = 10272, NG = 10240;
constexpr int C_LRUX = 0, C_LRUG = 1024, C_GLAQ = 2048, C_GLAK = 2560, C_GLAV = 3072, C_GLAG = 4096, C_SWAQ = 5120, C_SWAK = 6144,
              C_SWAV = 6400, C_SWAG = 6656, C_GLBQ = 7680, C_GLBK = 8704, C_GLBV = 8960, C_GLBG = 9216, C_LR = 10240;
constexpr size_t OUT_Y = 0, OUT_LRU = 33554432, OUT_GLA = 33619968, OUT_CACHE = 37814272;
constexpr int SHM_BYTES = 131072;
constexpr int SHM_TOTAL = SHM_BYTES + 256;

struct Params {
  const float *x_prompt, *x_sample, *c, *state_lru, *state_gla, *cswk, *cswv, *cglk, *cglv, *c_ctx, *norm_w, *w_mod, *b_mod, *w_in,
      *conv_w, *conv_b, *lru_wa, *lru_ba, *lru_wx, *lru_bx, *lru_lam, *gla_wup, *gla_bup, *gla_norm, *swa_sink, *qnorm, *knorm, *w_out, *final_norm;
  float* out;
  bfu *WinT, *WlrT, *WoutT, *WgT, *hbuf, *u, *merged, *Qb, *Kb, *Vb;
  float *modv, *rope, *lsum, *kv, *dec;
  bfu* scan;
  bfu* xbuf;
  float* sp8;
  unsigned* ctr;
  unsigned* bar;
  long never;
};

extern __shared__ __attribute__((aligned(16))) bf16 shm[];

template <typename T> __device__ __forceinline__ T opq(T x) { asm volatile("" : "+s"(x)); return x; }
__device__ __forceinline__ int otid() { int t = threadIdx.x; asm volatile("" : "+v"(t)); return t; }
__device__ __forceinline__ float bf2f(bfu h) { return __uint_as_float(((unsigned)h) << 16); }
__device__ __forceinline__ unsigned cvtpk(float lo, float hi) {
  unsigned r; asm volatile("v_cvt_pk_bf16_f32 %0, %1, %2" : "=v"(r) : "v"(lo), "v"(hi)); return r;
}
__device__ __forceinline__ bfu f2bf(float f) { return (bfu)(cvtpk(f, 0.f) & 0xffffu); }
__device__ __forceinline__ float f4get(float4 v, int j) { return j == 0 ? v.x : (j == 1 ? v.y : (j == 2 ? v.z : v.w)); }
__device__ __forceinline__ float silu(float v) { return v * __builtin_amdgcn_rcpf(1.f + __expf(-v)); }
__device__ __forceinline__ float sigmoidf(float v) { return 1.f / (1.f + __expf(-v)); }
__device__ __forceinline__ float wave_sum(float v) {
#pragma unroll
  for (int o = 32; o; o >>= 1) v += __shfl_xor(v, o);
  return v;
}
__device__ __forceinline__ void unpack8(uint4 v, float* f) {
  f[0] = __uint_as_float(v.x << 16); f[1] = __uint_as_float(v.x & 0xffff0000u);
  f[2] = __uint_as_float(v.y << 16); f[3] = __uint_as_float(v.y & 0xffff0000u);
  f[4] = __uint_as_float(v.z << 16); f[5] = __uint_as_float(v.z & 0xffff0000u);
  f[6] = __uint_as_float(v.w << 16); f[7] = __uint_as_float(v.w & 0xffff0000u);
}
__device__ __forceinline__ uint4 pack8(const float* f) {
  uint4 r; r.x = cvtpk(f[0], f[1]); r.y = cvtpk(f[2], f[3]); r.z = cvtpk(f[4], f[5]); r.w = cvtpk(f[6], f[7]); return r;
}
__device__ __forceinline__ f32x4 tile16(f32x4 acc, const bfu* A, int lda, const bfu* B, int ldb, int m0, int n0, int K, int lane) {
  const int fr = lane & 15, fq = lane >> 4;
  for (int k0 = 0; k0 < K; k0 += 32) {
    bf16x8 a = *reinterpret_cast<const bf16x8*>(A + (m0 + fr) * lda + k0 + fq * 8);
    bf16x8 b = *reinterpret_cast<const bf16x8*>(B + (n0 + fr) * ldb + k0 + fq * 8);
    acc = __builtin_amdgcn_mfma_f32_16x16x32_bf16(b, a, acc, 0, 0, 0);
  }
  return acc;
}

__device__ __forceinline__ void p0_gemv(const Params& p, int job, char* lds) {
  const int l = job >> 7, j0 = (job & 127) * 96, tid = otid();
  float* sv = (float*)lds;
  const float* cctx = opq(p.c_ctx); const float* clat = opq(p.c);
  for (int i = tid; i < 3 * 4096; i += 512) {
    int r = i >> 12, k = i & 4095;
    float v = (r == 0) ? cctx[k] : clat[(r - 1) * 4096 + k];
    sv[i] = v / (1.f + expf(-v));
  }
  __syncthreads();
  float a00 = 0, a01 = 0, a02 = 0, a03 = 0, a10 = 0, a11 = 0, a12 = 0, a13 = 0, a20 = 0, a21 = 0, a22 = 0, a23 = 0;
  const int cl = tid % 24, rl = tid / 24;
  if (rl < 21) {
    const float* W = p.w_mod + (size_t)l * 4096 * 12288 + j0 + cl * 4;
#pragma unroll 8
    for (int k = rl; k < 4096; k += 21) {
      float4 w = *(const float4*)(W + (size_t)k * 12288);
      float s0 = sv[k], s1 = sv[4096 + k], s2 = sv[8192 + k];
      a00 += s0 * w.x; a01 += s0 * w.y; a02 += s0 * w.z; a03 += s0 * w.w;
      a10 += s1 * w.x; a11 += s1 * w.y; a12 += s1 * w.z; a13 += s1 * w.w;
      a20 += s2 * w.x; a21 += s2 * w.y; a22 += s2 * w.z; a23 += s2 * w.w;
    }
  }
  float* red = (float*)(lds + 49152);
  if (rl < 21) {
    float* r0 = red + (rl * 3) * 96 + cl * 4;
    r0[0] = a00; r0[1] = a01; r0[2] = a02; r0[3] = a03;
    r0[96] = a10; r0[97] = a11; r0[98] = a12; r0[99] = a13;
    r0[192] = a20; r0[193] = a21; r0[194] = a22; r0[195] = a23;
  }
  __syncthreads();
  if (tid < 288) {
    int r = tid / 96, j = tid % 96; float s = 0;
    for (int q = 0; q < 21; ++q) s += red[(q * 3 + r) * 96 + j];
    p.modv[(l * 3 + r) * 12288 + j0 + j] = s + p.b_mod[l * 12288 + j0 + j];
  }
  __syncthreads();
}

struct TUnit { const float* src; size_t ldsrc; int k0; bfu* dst; };
__device__ __forceinline__ TUnit p0_unit(const Params& p, int j) {
  TUnit u;
  const float* win = opq(p.w_in); const float* wout = opq(p.w_out); bfu* WinT = opq(p.WinT); bfu* WlrT = opq(p.WlrT); bfu* WoutT = opq(p.WoutT);
  if (j < 2 * 8 * 321) {
    int l = j / (8 * 321), r = j % (8 * 321), kb = r / 321, nt = r % 321, nsrc0 = nt * 32;
    if (nsrc0 < 4096) u.dst = WinT + (size_t)l * NG * 4096 + (size_t)nsrc0 * 4096;
    else if (nsrc0 < 4128) u.dst = WlrT + (size_t)l * 32 * 4096;
    else u.dst = WinT + (size_t)l * NG * 4096 + (size_t)(nsrc0 - 32) * 4096;
    u.src = win + (size_t)l * 4096 * NU + nsrc0; u.ldsrc = NU; u.k0 = kb * 512;
  } else {
    j -= 2 * 8 * 321;
    int l = j / (8 * 128), r = j % (8 * 128), kb = r / 128, nt = r % 128, nsrc0 = nt * 32;
    u.dst = WoutT + (size_t)l * 4096 * 4096 + (size_t)nsrc0 * 4096;
    u.src = wout + (size_t)l * 4096 * 4096 + nsrc0; u.ldsrc = 4096; u.k0 = kb * 512;
  }
  return u;
}
__device__ __forceinline__ void p0_tload(const TUnit& u, int tid, float4* v) {
  const int c4 = tid & 7, r0 = tid >> 3;
#pragma unroll
  for (int i = 0; i < 8; ++i) v[i] = *(const float4*)(u.src + (size_t)(u.k0 + r0 + 64 * i) * u.ldsrc + c4 * 4);
}
__device__ __forceinline__ void p0_tstore(const TUnit& u, int tid, const float4* v, char* lds) {
  bfu* T = (bfu*)lds;
  const int c4 = tid & 7, r0 = tid >> 3;
#pragma unroll
  for (int i = 0; i < 8; ++i) {
    int k = r0 + 64 * i;
    T[(c4 * 4 + 0) * 520 + k] = f2bf(v[i].x); T[(c4 * 4 + 1) * 520 + k] = f2bf(v[i].y);
    T[(c4 * 4 + 2) * 520 + k] = f2bf(v[i].z); T[(c4 * 4 + 3) * 520 + k] = f2bf(v[i].w);
  }
  __syncthreads();
#pragma unroll
  for (int i = 0; i < 4; ++i) {
    int id = tid + 512 * i, n = id >> 6, kc = id & 63;
    uint4 val = *(const uint4*)(T + n * 520 + kc * 8);
    *(uint4*)(u.dst + (size_t)n * 4096 + u.k0 + kc * 8) = val;
  }
  __syncthreads();
}
__device__ __forceinline__ void p0_transposes(const Params& p, char* lds) {
  const int tid = otid(); constexpr int NUNIT = 2 * 8 * 321 + 2 * 8 * 128;
  int j = blockIdx.x;
  if (j >= NUNIT) return;
  float4 va[8], vb[8];
  TUnit ua = p0_unit(p, j), ub = ua;
  p0_tload(ua, tid, va);
  for (;;) {
    int jn = j + gridDim.x; bool hb = jn < NUNIT;
    if (hb) { ub = p0_unit(p, jn); p0_tload(ub, tid, vb); }
    p0_tstore(ua, tid, va, lds);
    if (!hb) break;
    j = jn + gridDim.x; bool ha = j < NUNIT;
    if (ha) { ua = p0_unit(p, j); p0_tload(ua, tid, va); }
    p0_tstore(ub, tid, vb, lds);
    if (!ha) break;
  }
}

constexpr int P0_GEMV = 256, P0_TIN = 2 * 8 * 321, P0_TOUT = 2 * 8 * 128, P0_WG = 64, P0_ROPE = 256, P0_SP = 8;
constexpr int P0_JOBS = P0_GEMV + P0_TIN + P0_TOUT + P0_WG + P0_ROPE + P0_SP;

__device__ __forceinline__ void phase0(const Params& p, char* lds) {
  if (blockIdx.x == 0 && threadIdx.x < 16) p.ctr[threadIdx.x] = 0;
  for (int job = blockIdx.x; job < P0_JOBS; job += gridDim.x) {
    int j = job;
    if (j < P0_GEMV) { p0_gemv(p, j, lds); continue; }
    j -= P0_GEMV;
    if (j < P0_TIN + P0_TOUT) continue;
    j -= P0_TIN + P0_TOUT;
    if (j < P0_WG) {
      int l = j >> 5, m = (j >> 3) & 3, hb = j & 7, d = m >> 1;
      const float* wxp = opq(p.lru_wx); const float* wap = opq(p.lru_wa);
      const float* src = ((m & 1) ? wxp : wap) + (size_t)((l * 2 + d) * 8 + hb) * 16384;
      bfu* dst = p.WgT + (size_t)j * 16384;
      for (int idx = otid(); idx < 16384; idx += 512) { int jj = idx >> 7, ii = idx & 127; dst[idx] = f2bf(src[ii * 128 + jj]); }
      continue;
    }
    j -= P0_WG;
    if (j >= P0_ROPE) {
      const int e = (j - P0_ROPE) * 512 + otid();
      const float nl = -p.lru_lam[e];
      p.sp8[e] = -8.f * (fmaxf(nl, 0.f) + log1pf(expf(-fabsf(nl))));
      continue;
    }
    {
      int e = j * 512 + otid(), t = e >> 6, a = (e >> 5) & 1, c = e & 31;
      float pos = (float)(a == 0 ? (t >> 6) : (t & 63));
      float inv = powf(10000.f, -(float)c / 32.f);
      float sn, cs; sincosf(pos * inv, &sn, &cs);
      p.rope[e * 2] = cs; p.rope[e * 2 + 1] = sn;
    }
  }
  p0_transposes(p, lds);
}

__device__ __forceinline__ const float* xrow_ptr(const Params& p, int row) {
  const float* xp = opq(p.x_prompt); const float* xs = opq(p.x_sample);
  return row < 4096 ? xp + (size_t)row * 4096 : xs + (size_t)(row - 4096) * 4096;
}
__device__ __forceinline__ void phase_norm(const Params& p, int l, char* lds) {
  float* WA = (float*)lds;
  float* WB = (float*)(lds + 16384);
  for (int rb = blockIdx.x; rb < 256; rb += gridDim.x) {
    const int tid = otid(), wid = tid >> 6, lane = tid & 63;
    const int row0 = rb * 32, cond = row0 < 4096 ? 0 : (row0 < 6144 ? 1 : 2);
    __syncthreads();
    if (l != 2) {
      const float* mv = p.modv + (l * 3 + cond) * 12288;
      for (int i = tid; i < 1024; i += 512) {
        const float4 w = *(const float4*)(p.norm_w + l * 4096 + i * 4), sh = *(const float4*)(mv + i * 4), sc = *(const float4*)(mv + 4096 + i * 4);
        *(float4*)(WA + i * 4) = make_float4(w.x * (1.f + sc.x), w.y * (1.f + sc.y), w.z * (1.f + sc.z), w.w * (1.f + sc.w));
        *(float4*)(WB + i * 4) = sh;
      }
    }
    __syncthreads();
#pragma unroll 1
    for (int i = 0; i < 4; ++i) {
      const int row = row0 + wid * 4 + i;
      float4 v[16]; float ss = 0;
      if (l == 0) {
        const float* xr = xrow_ptr(p, row);
#pragma unroll
        for (int q = 0; q < 16; ++q) v[q] = ((const float4*)xr)[lane + 64 * q];
      } else {
        const uint4* xr = (const uint4*)(p.xbuf + (size_t)row * 4096);
#pragma unroll
        for (int q2 = 0; q2 < 8; ++q2) {
          float t8[8]; unpack8(xr[lane + 64 * q2], t8);
          v[2 * q2] = make_float4(t8[0], t8[1], t8[2], t8[3]); v[2 * q2 + 1] = make_float4(t8[4], t8[5], t8[6], t8[7]);
        }
      }
#pragma unroll
      for (int q = 0; q < 16; ++q) ss += v[q].x * v[q].x + v[q].y * v[q].y + v[q].z * v[q].z + v[q].w * v[q].w;
      ss = wave_sum(ss);
#define NCOL(q) (l == 0 ? (lane + 64 * (q)) * 4 : (lane + 64 * ((q) >> 1)) * 8 + ((q) & 1) * 4)
      const float rs = rsqrtf(ss * (1.f / 4096.f) + 1e-6f);
      if (l == 2) {
        float4 wv[16];
#pragma unroll
        for (int q = 0; q < 16; ++q) wv[q] = *(const float4*)(p.final_norm + NCOL(q));
#pragma unroll
        for (int q = 0; q < 16; ++q) {
          const int col = NCOL(q); const float4 w = wv[q];
          *(float4*)(p.out + OUT_Y + (size_t)row * 4096 + col) = make_float4(v[q].x * rs * w.x, v[q].y * rs * w.y, v[q].z * rs * w.z, v[q].w * rs * w.w);
        }
      } else {
#pragma unroll
        for (int q = 0; q < 16; ++q) {
          const int col = NCOL(q); const float4 a = *(const float4*)(WA + col), b = *(const float4*)(WB + col);
          uint2 o; o.x = cvtpk(v[q].x * rs * a.x + b.x, v[q].y * rs * a.y + b.y); o.y = cvtpk(v[q].z * rs * a.z + b.z, v[q].w * rs * a.w + b.w);
          *(uint2*)(p.hbuf + (size_t)row * 4096 + col) = o;
        }
      }
#undef NCOL
    }
  }
}

constexpr int BM = 256, BK = 64, HALF = 128, NXCD = 8, WGM = 8, HT = HALF * BK;
__device__ __forceinline__ int lds_byte(int r, int c) {
  int st = (r >> 4) * 2 + (c >> 5), rr = r & 15, cc = c & 31, ob = rr * 64 + cc * 2;
  return st * 1024 + (ob ^ (((ob >> 9) & 1) << 5));
}
__device__ __forceinline__ void stage_rc(int b, int& R, int& C) {
  int st = b / 1024, sb = b % 1024, swz = sb ^ (((sb >> 9) & 1) << 5);
  R = (st >> 1) * 16 + swz / 64; C = (st & 1) * 32 + (swz % 64) / 2;
}

template <int MODE>
__device__ __forceinline__ void gemm_tile(const Params& p, int l, const bf16* __restrict__ A, const bf16* __restrict__ Bt, int nN, int wgid) {
  constexpr int K = 4096;
#define SA(b, h) (shm + ((b) * 2 + (h)) * HT)
#define SB(b, h) (shm + (4 + (b) * 2 + (h)) * HT)
#define STAGE(P, BASE, br, kt) do { long _g = (long)(br) * K + (long)(kt) * BK; \
    for (int _i = 0; _i < 2; ++_i) { int _b = tx * 16 + _i * 8192; int _r, _c; stage_rc(_b, _r, _c); \
      __builtin_amdgcn_global_load_lds((const unsigned*)(BASE + _g + (long)_r * K + _c), \
        (unsigned*)((char*)(P) + _b), 16, 0, 0); } } while (0)
#define LDA(dst, b, h) for (int m = 0; m < 4; ++m) for (int k = 0; k < 2; ++k) \
    dst[m][k] = *reinterpret_cast<const bf16x8*>((char*)SA(b, h) + lds_byte(wr * 64 + m * 16 + fr, k * 32 + fq * 8))
#define LDB(dst, b, h) for (int n = 0; n < 2; ++n) for (int k = 0; k < 2; ++k) \
    dst[n][k] = *reinterpret_cast<const bf16x8*>((char*)SB(b, h) + lds_byte(wc * 32 + n * 16 + fr, k * 32 + fq * 8))
#define MMA(ai, bj, At, Bt_) do { __builtin_amdgcn_s_setprio(1); \
    for (int m = 0; m < 4; ++m) for (int n = 0; n < 2; ++n) for (int k = 0; k < 2; ++k) \
      acc[ai][bj][m][n] = __builtin_amdgcn_mfma_f32_16x16x32_bf16(Bt_[n][k], At[m][k], acc[ai][bj][m][n], 0, 0, 0); \
    __builtin_amdgcn_s_setprio(0); } while (0)
#define WAIT_V(n) asm volatile("s_waitcnt vmcnt(" #n ")" ::: "memory")
#define WAIT_L(n) asm volatile("s_waitcnt lgkmcnt(" #n ")" ::: "memory")
#define BAR __builtin_amdgcn_s_barrier()
#define SCHED __builtin_amdgcn_sched_barrier(0)
  const int nM = 32, nwg = nM * nN;
  {
    int q = nwg / NXCD, r = nwg % NXCD, xcd = wgid % NXCD, off = wgid / NXCD;
    wgid = (xcd < r ? xcd * (q + 1) : r * (q + 1) + (xcd - r) * q) + off;
  }
  int nig = WGM * nN, gid = wgid / nig, fm = gid * WGM, gsz = min(nM - fm, WGM);
  int pm = fm + ((wgid % nig) % gsz), pn = (wgid % nig) / gsz, brow = pm * BM, bcol = pn * BM;
  int tx = threadIdx.x; asm volatile("" : "+v"(tx));
  int wid = __builtin_amdgcn_readfirstlane(tx >> 6), lane = tx & 63, wr = wid >> 2, wc = wid & 3, fr = lane & 15, fq = lane >> 4;
  f32x4 acc[2][2][4][2] = {};
  bf16x8 At[4][2], B0[2][2], B1[2][2];
  const int nt = K / BK;
  STAGE(SB(0, 0), Bt, bcol, 0); STAGE(SA(0, 0), A, brow, 0);
  STAGE(SB(0, 1), Bt, bcol + HALF, 0); STAGE(SA(0, 1), A, brow + HALF, 0);
  if (wr == 1) BAR;
  WAIT_V(4); BAR;
  STAGE(SB(1, 0), Bt, bcol, 1); STAGE(SA(1, 0), A, brow, 1); STAGE(SB(1, 1), Bt, bcol + HALF, 1);
  WAIT_V(6); BAR;
  for (int t = 0; t < nt - 2; t += 2) {
    LDB(B0, 0, 0); SCHED; LDA(At, 0, 0); STAGE(SA(1, 1), A, brow + HALF, t + 1);
    WAIT_L(8); BAR; WAIT_L(0); MMA(0, 0, At, B0); BAR; SCHED;
    LDB(B1, 0, 1); STAGE(SB(0, 0), Bt, bcol, t + 2);
    BAR; WAIT_L(0); MMA(0, 1, At, B1); BAR;
    LDA(At, 0, 1); STAGE(SA(0, 0), A, brow, t + 2);
    BAR; WAIT_L(0); MMA(1, 0, At, B0); BAR; SCHED;
    STAGE(SB(0, 1), Bt, bcol + HALF, t + 2);
    WAIT_V(6); BAR; MMA(1, 1, At, B1); BAR;
    LDB(B0, 1, 0); SCHED; LDA(At, 1, 0); STAGE(SA(0, 1), A, brow + HALF, t + 2);
    WAIT_L(8); BAR; WAIT_L(0); MMA(0, 0, At, B0); BAR; SCHED;
    LDB(B1, 1, 1); STAGE(SB(1, 0), Bt, bcol, t + 3);
    BAR; WAIT_L(0); MMA(0, 1, At, B1); BAR;
    LDA(At, 1, 1); STAGE(SA(1, 0), A, brow, t + 3);
    BAR; WAIT_L(0); MMA(1, 0, At, B0); BAR; SCHED;
    STAGE(SB(1, 1), Bt, bcol + HALF, t + 3);
    WAIT_V(6); BAR; MMA(1, 1, At, B1); BAR;
  }
  { LDB(B0, 0, 0); LDA(At, 0, 0); STAGE(SA(1, 1), A, brow + HALF, nt - 1);
    BAR; WAIT_L(0); MMA(0, 0, At, B0); BAR;
    LDB(B1, 0, 1); BAR; WAIT_L(0); MMA(0, 1, At, B1); BAR;
    LDA(At, 0, 1); WAIT_V(4); BAR; WAIT_L(0); MMA(1, 0, At, B0); MMA(1, 1, At, B1); BAR; }
  { LDB(B0, 1, 0); LDA(At, 1, 0); WAIT_V(2); BAR; WAIT_L(0); MMA(0, 0, At, B0); BAR;
    LDB(B1, 1, 1); WAIT_V(0); BAR; WAIT_L(0); MMA(0, 1, At, B1); BAR;
    LDA(At, 1, 1); BAR; WAIT_L(0); MMA(1, 0, At, B0); MMA(1, 1, At, B1); BAR; }
  if (wr == 0) BAR;
  int tx2 = threadIdx.x; asm volatile("" : "+v"(tx2));
  wid = __builtin_amdgcn_readfirstlane(tx2 >> 6); lane = tx2 & 63; wr = wid >> 2; wc = wid & 3; fr = lane & 15; fq = lane >> 4;
  if (MODE == 0) {
#pragma unroll
    for (int ai = 0; ai < 2; ++ai)
#pragma unroll
      for (int m = 0; m < 4; ++m) {
        const int row = brow + ai * HALF + wr * 64 + m * 16 + fr;
#pragma unroll
        for (int bj = 0; bj < 2; ++bj) {
          const f32x4 a0 = acc[ai][bj][m][0], a1 = acc[ai][bj][m][1];
          uint2 o0, o1; o0.x = cvtpk(a0[0], a0[1]); o0.y = cvtpk(a0[2], a0[3]); o1.x = cvtpk(a1[0], a1[1]); o1.y = cvtpk(a1[2], a1[3]);
          const bool odd = fq & 1;
          const unsigned sx = odd ? o0.x : o1.x, sy = odd ? o0.y : o1.y;
          const unsigned rx = (unsigned)__shfl_xor((int)sx, 16), ry = (unsigned)__shfl_xor((int)sy, 16);
          uint4 o; int col;
          if (!odd) { o = make_uint4(o0.x, o0.y, rx, ry); col = bcol + bj * HALF + wc * 32 + fq * 4; }
          else { o = make_uint4(rx, ry, o1.x, o1.y); col = bcol + bj * HALF + wc * 32 + 16 + (fq - 1) * 4; }
          *(uint4*)(p.u + (size_t)row * NU + col) = o;
        }
      }
  } else {
    const int cond = brow < 4096 ? 0 : (brow < 6144 ? 1 : 2);
    float4 g[2][2];
#pragma unroll
    for (int bj = 0; bj < 2; ++bj)
#pragma unroll
      for (int n = 0; n < 2; ++n) g[bj][n] = *(const float4*)(p.modv + (l * 3 + cond) * 12288 + 8192 + bcol + bj * HALF + wc * 32 + n * 16 + fq * 4);
#pragma unroll
    for (int ai = 0; ai < 2; ++ai) {
      float4 xo[4][2][2];
#pragma unroll
      for (int m = 0; m < 4; ++m) {
        const int row = brow + ai * HALF + wr * 64 + m * 16 + fr;
        if (l == 0) {
          const float* xr = xrow_ptr(p, row);
#pragma unroll
          for (int bj = 0; bj < 2; ++bj)
#pragma unroll
            for (int n = 0; n < 2; ++n) xo[m][bj][n] = *(const float4*)(xr + bcol + bj * HALF + wc * 32 + n * 16 + fq * 4);
        } else {
          const bfu* xr = p.xbuf + (size_t)row * 4096;
#pragma unroll
          for (int bj = 0; bj < 2; ++bj)
#pragma unroll
            for (int n = 0; n < 2; ++n) {
              const uint2 r = *(const uint2*)(xr + bcol + bj * HALF + wc * 32 + n * 16 + fq * 4);
              xo[m][bj][n] = make_float4(__uint_as_float(r.x << 16), __uint_as_float(r.x & 0xffff0000u), __uint_as_float(r.y << 16), __uint_as_float(r.y & 0xffff0000u));
            }
        }
      }
#pragma unroll
      for (int m = 0; m < 4; ++m) {
        const int row = brow + ai * HALF + wr * 64 + m * 16 + fr;
#pragma unroll
        for (int bj = 0; bj < 2; ++bj) {
          uint2 on[2];
#pragma unroll
          for (int n = 0; n < 2; ++n) {
            const f32x4 a = acc[ai][bj][m][n]; const float4 x4 = xo[m][bj][n], g4 = g[bj][n];
            on[n].x = cvtpk(x4.x + g4.x * a[0], x4.y + g4.y * a[1]); on[n].y = cvtpk(x4.z + g4.z * a[2], x4.w + g4.w * a[3]);
          }
          const bool odd = fq & 1;
          const unsigned sx = odd ? on[0].x : on[1].x, sy = odd ? on[0].y : on[1].y;
          const unsigned rx = (unsigned)__shfl_xor((int)sx, 16), ry = (unsigned)__shfl_xor((int)sy, 16);
          uint4 o; int col;
          if (!odd) { o = make_uint4(on[0].x, on[0].y, rx, ry); col = bcol + bj * HALF + wc * 32 + fq * 4; }
          else { o = make_uint4(rx, ry, on[1].x, on[1].y); col = bcol + bj * HALF + wc * 32 + 16 + (fq - 1) * 4; }
          *(uint4*)(p.xbuf + (size_t)row * 4096 + col) = o;
        }
      }
    }
  }
  __syncthreads();
#undef SA
#undef SB
#undef STAGE
#undef LDA
#undef LDB
#undef MMA
}

__device__ __forceinline__ void lr_tile(const Params& p, int l, int rb, char* lds) {
  const int tid = otid(), w = tid >> 6, lane = tid & 63, fr = lane & 15, fq = lane >> 4, row0 = rb * 32;
  const bfu* A = p.hbuf + (size_t)row0 * 4096; const bfu* B = p.WlrT + (size_t)l * 32 * 4096;
  f32x4 acc[2][2] = {};
  for (int k0 = w * 512; k0 < w * 512 + 512; k0 += 128) {
    bf16x8 a[4][2], b[4][2];
#pragma unroll
    for (int s4 = 0; s4 < 4; ++s4)
#pragma unroll
      for (int i = 0; i < 2; ++i) {
        a[s4][i] = *reinterpret_cast<const bf16x8*>(A + (size_t)(i * 16 + fr) * 4096 + k0 + s4 * 32 + fq * 8);
        b[s4][i] = *reinterpret_cast<const bf16x8*>(B + (size_t)(i * 16 + fr) * 4096 + k0 + s4 * 32 + fq * 8);
      }
#pragma unroll
    for (int s4 = 0; s4 < 4; ++s4)
#pragma unroll
      for (int mi = 0; mi < 2; ++mi)
#pragma unroll
        for (int ni = 0; ni < 2; ++ni)
          acc[mi][ni] = __builtin_amdgcn_mfma_f32_16x16x32_bf16(b[s4][ni], a[s4][mi], acc[mi][ni], 0, 0, 0);
  }
  float* red = (float*)lds;
#pragma unroll
  for (int mi = 0; mi < 2; ++mi)
#pragma unroll
    for (int ni = 0; ni < 2; ++ni)
#pragma unroll
      for (int j = 0; j < 4; ++j)
        red[w * 1024 + (mi * 16 + fr) * 32 + ni * 16 + fq * 4 + j] = acc[mi][ni][j];
  __syncthreads();
  for (int e = tid; e < 1024; e += 512) {
    float s = 0;
    for (int q = 0; q < 8; ++q) s += red[q * 1024 + e];
    p.u[(size_t)(row0 + (e >> 5)) * NU + C_LR + (e & 31)] = f2bf(s);
  }
  __syncthreads();
}

__device__ __forceinline__ void phase_gemm_in(const Params& p, int l, char* lds) {
  const bf16* A = (const bf16*)p.hbuf; const bf16* Bt = (const bf16*)(p.WinT + (size_t)l * NG * 4096);
  for (int t = blockIdx.x; t < 1280; t += gridDim.x) gemm_tile<0>(p, l, A, Bt, 40, t);
  for (int rb = blockIdx.x; rb < 256; rb += gridDim.x) lr_tile(p, l, rb, lds);
}
__device__ __forceinline__ void phase_gemm_out(const Params& p, int l) {
  const bf16* A = (const bf16*)p.merged; const bf16* Bt = (const bf16*)(p.WoutT + (size_t)l * 4096 * 4096);
  for (int t = blockIdx.x; t < 512; t += gridDim.x) gemm_tile<1>(p, l, A, Bt, 16, t);
}

__device__ __forceinline__ void seq_of_row(int row0, int& seq_start, int& T) {
  if (row0 < 4096) { seq_start = row0 & ~255; T = 256; } else { seq_start = 4096 + ((row0 - 4096) & ~2047); T = 2048; }
}

#define LDS_BAR() asm volatile("s_waitcnt lgkmcnt(0)\n\ts_barrier" ::: "memory")
__device__ __forceinline__ void lru_m1(const Params& p, int l, int jt, int hb, char* lds) {
  const int tid = otid(), wid = tid >> 6, lane = tid & 63, fr = lane & 15, fq = lane >> 4;
  const int row0 = jt * 64; int seq_start, T; seq_of_row(row0, seq_start, T);
  float* XIN = (float*)lds;
  float* AV = (float*)lds;
  float* XC = (float*)(lds + 34304);
  bfu* XA = (bfu*)(lds + 67328);
  bfu* WB = (bfu*)(lds + 84736);
  float* INP = (float*)(lds + 67328);
  float* SUM = (float*)(lds + 100352);
  const int wr = wid >> 2, wc = wid & 3;
  uint4 raw[3]; bool okv[3];
#pragma unroll
  for (int i = 0; i < 3; ++i) {
    const int id = tid + 512 * i, r = id >> 4, row = row0 - 2 + r;
    okv[i] = id < 67 * 16 && row >= seq_start && row < seq_start + T;
    const int rowc = okv[i] ? row : row0;
    raw[i] = *(const uint4*)(p.u + (size_t)rowc * NU + C_LRUX + hb * 128 + (id & 15) * 8);
  }
  const int cc = tid & 127, chc = hb * 128 + cc;
  const float w0 = p.conv_w[(l * 4 + 0) * 1024 + chc], w1 = p.conv_w[(l * 4 + 1) * 1024 + chc], w2 = p.conv_w[(l * 4 + 2) * 1024 + chc],
              w3 = p.conv_w[(l * 4 + 3) * 1024 + chc], cb = p.conv_b[l * 1024 + chc];
  float4 gba[2][2], gbx[2][2], glm[2][2];
#pragma unroll
  for (int d = 0; d < 2; ++d)
#pragma unroll
    for (int ni = 0; ni < 2; ++ni) {
      const int ch4 = (l * 2 + d) * 1024 + hb * 128 + wc * 32 + ni * 16 + fq * 4;
      gba[d][ni] = *(const float4*)(p.lru_ba + ch4); gbx[d][ni] = *(const float4*)(p.lru_bx + ch4); glm[d][ni] = *(const float4*)(p.sp8 + ch4);
    }
  uint4 wg0, wg1, wg2, wg3;
  const int wsrc = (tid >> 4) * 128 + (tid & 15) * 8, wdst = (tid >> 4) * 136 + (tid & 15) * 8;
  {
    const bfu* src = p.WgT + (size_t)((l * 4 + 0) * 8 + hb) * 16384 + wsrc;
    wg0 = *(const uint4*)(src); wg1 = *(const uint4*)(src + 32 * 128); wg2 = *(const uint4*)(src + 64 * 128); wg3 = *(const uint4*)(src + 96 * 128);
  }
#pragma unroll
  for (int i = 0; i < 3; ++i) {
    const int id = tid + 512 * i;
    if (id < 67 * 16) {
      float xv[8]; unpack8(raw[i], xv);
      float* dstp = XIN + (id >> 4) * 128 + (id & 15) * 8;
      const float z = okv[i] ? 1.f : 0.f;
      *(float4*)dstp = make_float4(xv[0] * z, xv[1] * z, xv[2] * z, xv[3] * z);
      *(float4*)(dstp + 4) = make_float4(xv[4] * z, xv[5] * z, xv[6] * z, xv[7] * z);
    }
  }
  LDS_BAR();
  float xcv[16];
#pragma unroll
  for (int i = 0; i < 16; ++i) {
    const int t = (tid >> 7) + 4 * i;
    xcv[i] = w0 * XIN[t * 128 + cc] + w1 * XIN[(t + 1) * 128 + cc] + w2 * XIN[(t + 2) * 128 + cc] + w3 * XIN[(t + 3) * 128 + cc] + cb;
  }
#pragma unroll
  for (int i = 0; i < 16; ++i) { const int t = (tid >> 7) + 4 * i; XC[t * 129 + cc] = xcv[i]; XA[t * 136 + cc] = f2bf(xcv[i]); }
  f32x4 acc[4][2][2];
#pragma unroll
  for (int m = 0; m < 4; ++m) {
    if (m > 0) LDS_BAR();
    *(uint4*)(WB + wdst) = wg0; *(uint4*)(WB + wdst + 32 * 136) = wg1; *(uint4*)(WB + wdst + 64 * 136) = wg2; *(uint4*)(WB + wdst + 96 * 136) = wg3;
    if (m < 3) {
      const bfu* src = p.WgT + (size_t)((l * 4 + m + 1) * 8 + hb) * 16384 + wsrc;
      wg0 = *(const uint4*)(src); wg1 = *(const uint4*)(src + 32 * 128); wg2 = *(const uint4*)(src + 64 * 128); wg3 = *(const uint4*)(src + 96 * 128);
    }
    LDS_BAR();
#pragma unroll
    for (int mi = 0; mi < 2; ++mi)
#pragma unroll
      for (int ni = 0; ni < 2; ++ni) {
        f32x4 z = {0, 0, 0, 0};
        acc[m][mi][ni] = tile16(z, XA, 136, WB, 136, wr * 32 + mi * 16, wc * 32 + ni * 16, 128, lane);
      }
  }
#pragma unroll
  for (int d = 0; d < 2; ++d) {
    LDS_BAR();
#pragma unroll
    for (int ni = 0; ni < 2; ++ni)
#pragma unroll
      for (int j = 0; j < 4; ++j) {
        const int c = wc * 32 + ni * 16 + fq * 4 + j;
        const float ba = f4get(gba[d][ni], j), bx = f4get(gbx[d][ni], j);
        const float sp8 = f4get(glm[d][ni], j);
#pragma unroll
        for (int mi = 0; mi < 2; ++mi) {
          const int t = wr * 32 + mi * 16 + fr;
          const float r = __builtin_amdgcn_rcpf(1.f + __expf(-(acc[d * 2][mi][ni][j] + ba)));
          const float ig = __builtin_amdgcn_rcpf(1.f + __expf(-(acc[d * 2 + 1][mi][ni][j] + bx)));
          const float log_a = r * sp8, y = 2.f * log_a;
          const float a = __expf(log_a);
          const float om = (y > -0.05f) ? -y * (1.f + y * (0.5f + y * (0.16666667f + y * 0.041666667f))) : 1.f - __expf(y);
          AV[t * 129 + c] = a; INP[t * 129 + c] = __builtin_amdgcn_sqrtf(om) * (ig * XC[t * 129 + c]);
        }
      }
    LDS_BAR();
    {
      const int c = tid & 127, sg = tid >> 7, ch = hb * 128 + c;
      float hl[16], cl[16]; float H = 0.f, CP = 1.f;
#pragma unroll
      for (int s2 = 0; s2 < 16; ++s2) {
        const int q = sg * 16 + s2, t = d == 0 ? q : 63 - q;
        const float a = AV[t * 129 + c];
        H = a * H + INP[t * 129 + c]; CP *= a; hl[s2] = H; cl[s2] = CP;
      }
      SUM[(sg * 128 + c) * 2] = H; SUM[(sg * 128 + c) * 2 + 1] = CP;
      LDS_BAR();
      float Hc = 0.f, Cc = 1.f;
      for (int s3 = 0; s3 < sg; ++s3) { const float sh = SUM[(s3 * 128 + c) * 2], scp = SUM[(s3 * 128 + c) * 2 + 1]; Hc = sh + scp * Hc; Cc *= scp; }
      bfu* hlp = p.scan + (size_t)(d * 2) * 8388608; bfu* cpp_ = p.scan + (size_t)(d * 2 + 1) * 8388608;
#pragma unroll
      for (int s2 = 0; s2 < 16; ++s2) {
        const int q = sg * 16 + s2, t = d == 0 ? q : 63 - q;
        hlp[(size_t)(row0 + t) * 1024 + ch] = f2bf(hl[s2] + cl[s2] * Hc); cpp_[(size_t)(row0 + t) * 1024 + ch] = f2bf(cl[s2] * Cc);
      }
      if (sg == 3) *(float2*)(p.lsum + ((size_t)(d * 128 + jt) * 1024 + ch) * 2) = make_float2(hl[15] + cl[15] * Hc, cl[15] * Cc);
    }
  }
  LDS_BAR();
}

__device__ __forceinline__ void gla_prep(const Params& p, int l, int row0, int h, float* BC, char* scratch) {
  const int tid = otid();
  float* LRS = (float*)scratch;
  float* WUP = (float*)(scratch + 8192);
  float* BUP = (float*)(scratch + 16384);
  for (int idx = tid; idx < 2048; idx += 512) {
    LRS[idx] = bf2f(p.u[(size_t)(row0 + (idx >> 5)) * NU + C_LR + (idx & 31)]);
    int d = idx >> 10, r = (idx >> 6) & 15, dk = idx & 63;
    WUP[idx] = p.gla_wup[((size_t)(l * 2 + d) * 16 + r) * 512 + h * 64 + dk];
  }
  if (tid < 128) BUP[tid] = p.gla_bup[(l * 2 + (tid >> 6)) * 512 + h * 64 + (tid & 63)];
  __syncthreads();
  {
    const int dk = tid & 63, tq = tid >> 6;
#pragma unroll
    for (int d = 0; d < 2; ++d) {
      float w[16];
#pragma unroll
      for (int r = 0; r < 16; ++r) w[r] = WUP[(d * 16 + r) * 64 + dk];
      const float bu = BUP[d * 64 + dk];
#pragma unroll
      for (int i = 0; i < 8; ++i) {
        const int t = tq + 8 * i;
        const float4* lr4 = (const float4*)(LRS + t * 32 + d * 16);
        const float4 l0 = lr4[0], l1 = lr4[1], l2 = lr4[2], l3 = lr4[3];
        float z = bu + l0.x * w[0] + l0.y * w[1] + l0.z * w[2] + l0.w * w[3] + l1.x * w[4] + l1.y * w[5] + l1.z * w[6] + l1.w * w[7]
                + l2.x * w[8] + l2.y * w[9] + l2.z * w[10] + l2.w * w[11] + l3.x * w[12] + l3.y * w[13] + l3.z * w[14] + l3.w * w[15];
        float ls = fminf(z, 0.f) - __logf(1.f + __expf(-fabsf(z)));
        BC[(d * 64 + t) * 64 + dk] = ls * (1.f / 16.f);
      }
    }
  }
  __syncthreads();
  {
    const int pr = tid & 127, sg = tid >> 7, d = pr >> 6, dk = pr & 63;
    float* SEG = LRS;
    float v[16]; float sum = 0.f;
#pragma unroll
    for (int s2 = 0; s2 < 16; ++s2) { const int q = sg * 16 + s2, t = d == 0 ? q : 63 - q; sum += BC[(d * 64 + t) * 64 + dk]; v[s2] = sum; }
    SEG[sg * 128 + pr] = sum;
    __syncthreads();
    float off = 0.f;
    for (int s3 = 0; s3 < sg; ++s3) off += SEG[s3 * 128 + pr];
#pragma unroll
    for (int s2 = 0; s2 < 16; ++s2) { const int q = sg * 16 + s2, t = d == 0 ? q : 63 - q; BC[(d * 64 + t) * 64 + dk] = v[s2] + off; }
  }
  __syncthreads();
}

__device__ __forceinline__ void gla_m1(const Params& p, int l, int g, int h, char* lds) {
  const int tid = otid(), wid = tid >> 6, lane = tid & 63, fr = lane & 15, fq = lane >> 4, row0 = g * 64;
  float* BC = (float*)(lds + 17408);
  bfu* KT = (bfu*)(lds + 50176);
  bfu* VT = (bfu*)(lds + 68608);
  gla_prep(p, l, row0, h, BC, lds);
  {
    const int t = tid >> 3, s8 = tid & 7;
    float kf[8]; unpack8(*(const uint4*)(p.u + (size_t)(row0 + t) * NU + C_GLAK + h * 64 + s8 * 8), kf);
#pragma unroll
    for (int e = 0; e < 8; ++e) {
      int dk = s8 * 8 + e;
      KT[dk * 72 + t] = f2bf(kf[e] * __expf(BC[63 * 64 + dk] - BC[t * 64 + dk]));
      KT[(64 + dk) * 72 + t] = f2bf(kf[e] * __expf(BC[(64 + 0) * 64 + dk] - BC[(64 + t) * 64 + dk]));
    }
    const bfu* vp = p.u + (size_t)(row0 + t) * NU + C_GLAV + h * 128 + s8 * 16;
    float vf[16]; unpack8(*(const uint4*)vp, vf); unpack8(*(const uint4*)(vp + 8), vf + 8);
#pragma unroll
    for (int e = 0; e < 16; ++e) VT[(s8 * 16 + e) * 72 + t] = f2bf(vf[e]);
  }
  if (tid < 128) { int d = tid >> 6, dk = tid & 63; p.dec[((size_t)(g * 8 + h) * 2 + d) * 64 + dk] = __expf(d == 0 ? BC[63 * 64 + dk] : BC[64 * 64 + dk]); }
  __syncthreads();
  for (int d = 0; d < 2; ++d) {
    float* dst = p.kv + ((size_t)(g * 8 + h) * 2 + d) * 8192;
    for (int i = 0; i < 4; ++i) {
      const int m0 = wid * 16, n0 = i * 16;
      f32x4 z = {0, 0, 0, 0};
      f32x4 a = tile16(z, VT, 72, KT + d * 64 * 72, 72, m0, n0, 64, lane);
      *(float4*)(dst + (m0 + fr) * 64 + n0 + fq * 4) = *(float4*)&a;
    }
  }
  __syncthreads();
}

__device__ __forceinline__ void prep_job(const Params& p, int l, int j, int tid) {
  const int wid = tid >> 6, lane = tid & 63, sub = lane >> 4, c = lane & 15;
  bfu* kb_ = opq(p.Kb); bfu* vb_ = opq(p.Vb); const float* qn = opq(p.qnorm); const float* kn = opq(p.knorm);
  const bool lat = j >= 256;
  for (int it0 = wid; it0 < 96; it0 += 24) {
   uint4 rawv[3];
#pragma unroll
   for (int k = 0; k < 3; ++k) {
     const int it = it0 + 8 * k, tok = it / 6, grp = it % 6, row = j * 16 + tok, vec = grp * 4 + sub;
     const int glb = vec >= 12 ? 1 : 0, v12 = vec - glb * 12;
     rawv[k] = *(const uint4*)(p.u + (size_t)row * NU + (glb ? C_GLBQ : C_SWAQ) + v12 * 128 + c * 8);
   }
#pragma unroll
   for (int k = 0; k < 3; ++k) {
    const int it = it0 + 8 * k;
    const int tok = it / 6, grp = it % 6, row = j * 16 + tok, vec = grp * 4 + sub;
    int b, t;
    if (!lat) { b = row >> 8; t = row & 255; } else { int r = row - 4096; b = r >> 11; t = r & 2047; }
    const int glb = vec >= 12 ? 1 : 0, v12 = vec - glb * 12;
    const int kind = v12 < 8 ? 0 : (v12 < 10 ? 1 : 2), hh = kind == 0 ? v12 : (v12 & 1);
    float x[8]; unpack8(rawv[k], x);
    float ss = 0.f;
#pragma unroll
    for (int e = 0; e < 8; ++e) ss += x[e] * x[e];
    ss += __shfl_xor(ss, 1); ss += __shfl_xor(ss, 2); ss += __shfl_xor(ss, 4); ss += __shfl_xor(ss, 8);
    if (glb && kind < 2) {
      const float rs = rsqrtf(ss * (1.f / 128.f) + 1e-6f);
      const float* w = (kind == 0 ? qn : kn) + l * 128 + c * 8;
      float4 w0 = *(const float4*)w, w1 = *(const float4*)(w + 4);
      x[0] *= rs * w0.x; x[1] *= rs * w0.y; x[2] *= rs * w0.z; x[3] *= rs * w0.w;
      x[4] *= rs * w1.x; x[5] *= rs * w1.y; x[6] *= rs * w1.z; x[7] *= rs * w1.w;
    }
    float y[8];
#pragma unroll
    for (int e = 0; e < 8; ++e) y[e] = __shfl_xor(x[e], 4);
    if (lat && kind < 2) {
      const float* rt = p.rope + (size_t)t * 128 + ((c >> 3) * 32 + (c & 3) * 8) * 2;
      const float sgn = (c & 4) ? 1.f : -1.f;
#pragma unroll
      for (int e = 0; e < 8; e += 2) {
        float4 cs = *(const float4*)(rt + e * 2);
        x[e] = x[e] * cs.x + sgn * y[e] * cs.y; x[e + 1] = x[e + 1] * cs.z + sgn * y[e + 1] * cs.w;
      }
    }
    const int type = (lat ? 2 : 0) + glb;
    bfu* dst;
    if (kind == 0) { int T = lat ? 2048 : 256; dst = p.Qb + (size_t)type * 4194304 + ((size_t)(b * 8 + hh) * T + t) * 128; }
    else {
      int S = lat ? 2560 : 256, off = lat ? 512 : 0;
      size_t kvoff = type == 0 ? 0 : (type == 1 ? 1048576 : (type == 2 ? 2097152 : 3407872));
      dst = (kind == 1 ? kb_ : vb_) + kvoff + ((size_t)(b * 2 + hh) * S + off + t) * 128;
    }
    *(uint4*)(dst + c * 8) = pack8(x);
    if (!lat && kind > 0) {
      float* o = p.out + OUT_CACHE + (size_t)(glb * 2 + kind - 1) * 2097152 + ((size_t)((b * 2 + l) * 2 + hh) * 256 + t) * 128 + c * 8;
      *(float4*)o = make_float4(x[0], x[1], x[2], x[3]); *(float4*)(o + 4) = make_float4(x[4], x[5], x[6], x[7]);
    }
   }
  }
}

constexpr int M1_LRU = 1024, M1_GLA = 1024, M1_PREP = 512, M1_CACHE = 32, M1_JOBS = M1_LRU + M1_GLA + M1_PREP + M1_CACHE;
__device__ __forceinline__ void phase_m1(const Params& p, int l, char* lds) {
  for (int job = blockIdx.x; job < M1_JOBS; job += gridDim.x) {
    const int tid = otid(), wid = tid >> 6, lane = tid & 63;
    int j = job;
    if (j < M1_LRU) { lru_m1(p, l, j >> 3, j & 7, lds); continue; }
    j -= M1_LRU;
    if (j < M1_GLA) { gla_m1(p, l, j >> 3, j & 7, lds); continue; }
    j -= M1_GLA;
    if (j < M1_PREP) {
      prep_job(p, l, j, tid);
      continue;
    }
    j -= M1_PREP;
    {
      int arr = j >> 3, bk = (j >> 1) & 3, half = j & 1, b = bk >> 1, kvh = bk & 1;
      const float* s0 = opq(p.cswk); const float* s1 = opq(p.cswv); const float* s2 = opq(p.cglk); const float* s3 = opq(p.cglv);
      const float* src = s0;
      if (arr == 1) src = s1;
      if (arr == 2) src = s2;
      if (arr == 3) src = s3;
      src += (size_t)((b * 2 + l) * 2 + kvh) * 65536 + half * 32768;
      bfu* kb_ = opq(p.Kb); bfu* vb_ = opq(p.Vb);
      bfu* dst = ((arr & 1) ? vb_ : kb_) + (arr < 2 ? 2097152 : 3407872) + (size_t)(b * 2 + kvh) * 2560 * 128 + half * 32768;
      for (int i = tid * 8; i < 32768; i += 4096) {
        float4 a = *(const float4*)(src + i), c = *(const float4*)(src + i + 4);
        uint4 o; o.x = cvtpk(a.x, a.y); o.y = cvtpk(a.z, a.w); o.z = cvtpk(c.x, c.y); o.w = cvtpk(c.z, c.w);
        *(uint4*)(dst + i) = o;
      }
    }
  }
}

__device__ __forceinline__ void lru_m2(const Params& p, int l, int jt, int hb) {
  const int tid = otid(), c = tid & 127, tg = tid >> 7, ch = hb * 128 + c, row0 = jt * 64;
  int seq_start, T; seq_of_row(row0, seq_start, T);
  const bool lat = row0 >= 4096; const int b = lat ? (row0 - 4096) >> 11 : row0 >> 8;
  const bfu* hlf = p.scan; const bfu* cpf = p.scan + 8388608; const bfu* hlb = p.scan + 2 * 8388608; const bfu* cpb = p.scan + 3 * 8388608;
  const float* sumf = p.lsum; const float* sumb = p.lsum + (size_t)128 * 1024 * 2;
  float Hf = lat ? p.state_lru[(size_t)((b * 2 + l) * 2 + 0) * 1024 + ch] : 0.f;
  float Hb = lat ? p.state_lru[(size_t)((b * 2 + l) * 2 + 1) * 1024 + ch] : 0.f;
  for (int r = seq_start; r < row0; r += 512) {
    float hh[8], cc[8];
#pragma unroll
    for (int q = 0; q < 8; ++q) { int rr = r + q * 64; bool ok = rr < row0; const float2 sv = *(const float2*)(sumf + ((size_t)((ok ? rr : row0) >> 6) * 1024 + ch) * 2); hh[q] = ok ? sv.x : 0.f; cc[q] = ok ? sv.y : 1.f; }
#pragma unroll
    for (int q = 0; q < 8; ++q) Hf = hh[q] + cc[q] * Hf;
  }
  for (int r = seq_start + T - 64; r > row0; r -= 512) {
    float hh[8], cc[8];
#pragma unroll
    for (int q = 0; q < 8; ++q) { int rr = r - q * 64; bool ok = rr > row0; const float2 sv = *(const float2*)(sumb + ((size_t)((ok ? rr : row0) >> 6) * 1024 + ch) * 2); hh[q] = ok ? sv.x : 0.f; cc[q] = ok ? sv.y : 1.f; }
#pragma unroll
    for (int q = 0; q < 8; ++q) Hb = hh[q] + cc[q] * Hb;
  }
  bfu vhf[16], vcf[16], vhb[16], vcb[16]; bfu vg[16];
#pragma unroll
  for (int i = 0; i < 16; ++i) {
    const int row = row0 + tg * 16 + i; const size_t o = (size_t)row * 1024 + ch;
    vhf[i] = hlf[o]; vcf[i] = cpf[o]; vhb[i] = hlb[o]; vcb[i] = cpb[o]; vg[i] = p.u[(size_t)row * NU + C_LRUG + ch];
  }
#pragma unroll
  for (int i = 0; i < 16; ++i) {
    const int row = row0 + tg * 16 + i;
    const float of = bf2f(vhf[i]) + bf2f(vcf[i]) * Hf, ob = bf2f(vhb[i]) + bf2f(vcb[i]) * Hb;
    p.merged[(size_t)row * 4096 + ch] = f2bf((of + ob) * silu(bf2f(vg[i])));
    if (!lat) {
      if (row == seq_start + T - 1) p.out[OUT_LRU + (size_t)((b * 2 + l) * 2 + 0) * 1024 + ch] = of;
      if (row == seq_start) p.out[OUT_LRU + (size_t)((b * 2 + l) * 2 + 1) * 1024 + ch] = ob;
    }
  }
}

__device__ __forceinline__ void gla_m2(const Params& p, int l, int g, int h, char* lds) {
  const int tid = otid(), wid = tid >> 6, lane = tid & 63, fr = lane & 15, fq = lane >> 4, row0 = g * 64;
  const bool lat = row0 >= 4096; const int b = lat ? (row0 - 4096) >> 11 : row0 >> 8;
  const int gfirst = lat ? 64 + b * 32 : b * 4, glast = lat ? gfirst + 31 : gfirst + 3;
  float* BC = (float*)lds;
  bfu* SBm = (bfu*)lds;
  char* scratch = lds + 36864;
  bfu* PL = (bfu*)(lds + 36864);
  bfu* QI = (bfu*)(lds + 54272);
  bfu* QA = (bfu*)(lds + 71680);
  bfu* VT = (bfu*)(lds + 108544);
  float* OL = (float*)(lds + 54272);
  gla_prep(p, l, row0, h, BC, scratch);
  {
    const int t = tid >> 3, s8 = tid & 7;
    float qf[8], kf[8];
    unpack8(*(const uint4*)(p.u + (size_t)(row0 + t) * NU + C_GLAQ + h * 64 + s8 * 8), qf);
    unpack8(*(const uint4*)(p.u + (size_t)(row0 + t) * NU + C_GLAK + h * 64 + s8 * 8), kf);
    float qi0[8], qi1[8], qa0[8], ka0[8], qa1[8], ka1[8];
#pragma unroll
    for (int e = 0; e < 8; ++e) {
      const int dk = s8 * 8 + e; const float q = qf[e] * 0.125f, k = kf[e];
      const float bf = BC[t * 64 + dk], bb = BC[(64 + t) * 64 + dk], rf = BC[32 * 64 + dk], rb = BC[(64 + 31) * 64 + dk];
      qi0[e] = q * __expf(bf); qi1[e] = q * __expf(bb);
      qa0[e] = q * __expf(bf - rf); ka0[e] = k * __expf(rf - bf);
      qa1[e] = q * __expf(bb - rb); ka1[e] = k * __expf(rb - bb);
    }
    *(uint4*)(QI + t * 136 + s8 * 8) = pack8(qi0); *(uint4*)(QI + t * 136 + 64 + s8 * 8) = pack8(qi1);
    *(uint4*)(QA + t * 72 + s8 * 8) = pack8(qa0); *(uint4*)(QA + 4608 + t * 72 + s8 * 8) = pack8(ka0);
    *(uint4*)(QA + 9216 + t * 72 + s8 * 8) = pack8(qa1); *(uint4*)(QA + 13824 + t * 72 + s8 * 8) = pack8(ka1);
    const bfu* vp = p.u + (size_t)(row0 + t) * NU + C_GLAV + h * 128 + s8 * 16;
    float vf[16]; unpack8(*(const uint4*)vp, vf); unpack8(*(const uint4*)(vp + 8), vf + 8);
#pragma unroll
    for (int e = 0; e < 16; ++e) VT[(s8 * 16 + e) * 72 + t] = f2bf(vf[e]);
  }
  float4 Sf[4], Sb[4];
#pragma unroll
  for (int i = 0; i < 4; ++i) {
    const int idx4 = tid + 512 * i, dv = idx4 >> 4, dk0 = (idx4 & 15) * 4;
    if (lat) {
      const float* s0 = p.state_gla + ((size_t)((b * 2 + l) * 2 + 0) * 8 + h) * 8192 + dk0 * 128 + dv;
      const float* s1 = p.state_gla + ((size_t)((b * 2 + l) * 2 + 1) * 8 + h) * 8192 + dk0 * 128 + dv;
      Sf[i] = make_float4(s0[0], s0[128], s0[256], s0[384]); Sb[i] = make_float4(s1[0], s1[128], s1[256], s1[384]);
    } else { Sf[i] = make_float4(0.f, 0.f, 0.f, 0.f); Sb[i] = make_float4(0.f, 0.f, 0.f, 0.f); }
  }
#define GLA_STEP4(S, d, g0, dir, lim) do { float4 kk[4][4]; float4 dd[4][4];                                                   \
    _Pragma("unroll") for (int q = 0; q < 4; ++q) { int gq = (g0) + (dir) * q; bool ok = (dir) > 0 ? gq < (lim) : gq > (lim); int gc = ok ? gq : (lim); \
      const float* kvp = p.kv + ((size_t)(gc * 8 + h) * 2 + (d)) * 8192; const float* dp = p.dec + ((size_t)(gc * 8 + h) * 2 + (d)) * 64; \
      _Pragma("unroll") for (int i = 0; i < 4; ++i) { int idx4 = tid + 512 * i;                                                \
        kk[q][i] = ok ? *(const float4*)(kvp + idx4 * 4) : make_float4(0.f, 0.f, 0.f, 0.f);                                    \
        dd[q][i] = ok ? *(const float4*)(dp + (idx4 & 15) * 4) : make_float4(1.f, 1.f, 1.f, 1.f); } }                          \
    _Pragma("unroll") for (int q = 0; q < 4; ++q) _Pragma("unroll") for (int i = 0; i < 4; ++i) {                              \
      S[i].x = dd[q][i].x * S[i].x + kk[q][i].x; S[i].y = dd[q][i].y * S[i].y + kk[q][i].y;                                    \
      S[i].z = dd[q][i].z * S[i].z + kk[q][i].z; S[i].w = dd[q][i].w * S[i].w + kk[q][i].w; } } while (0)
  for (int gg = gfirst; gg < g; gg += 4) GLA_STEP4(Sf, 0, gg, 1, g);
  for (int gg = glast; gg > g; gg -= 4) GLA_STEP4(Sb, 1, gg, -1, g);
#undef GLA_STEP4
  if (!lat && (g == glast || g == gfirst)) {
#pragma unroll
    for (int d = 0; d < 2; ++d) {
      if (d == 0 ? g == glast : g == gfirst) {
        const float* kvp = p.kv + ((size_t)(g * 8 + h) * 2 + d) * 8192; const float* dp = p.dec + ((size_t)(g * 8 + h) * 2 + d) * 64;
        float* o = p.out + OUT_GLA + ((size_t)((b * 2 + l) * 2 + d) * 8 + h) * 8192;
#pragma unroll
        for (int i = 0; i < 4; ++i) {
          const int idx4 = tid + 512 * i, dv = idx4 >> 4, dk0 = (idx4 & 15) * 4;
          const float4 k4 = *(const float4*)(kvp + idx4 * 4), d4 = *(const float4*)(dp + dk0), S4 = d == 0 ? Sf[i] : Sb[i];
          o[(dk0 + 0) * 128 + dv] = d4.x * S4.x + k4.x; o[(dk0 + 1) * 128 + dv] = d4.y * S4.y + k4.y;
          o[(dk0 + 2) * 128 + dv] = d4.z * S4.z + k4.z; o[(dk0 + 3) * 128 + dv] = d4.w * S4.w + k4.w;
        }
      }
    }
  }
  __syncthreads();
#pragma unroll
  for (int i = 0; i < 4; ++i) {
    const int idx4 = tid + 512 * i, dv = idx4 >> 4, dk0 = (idx4 & 15) * 4;
    uint2 o0, o1; o0.x = cvtpk(Sf[i].x, Sf[i].y); o0.y = cvtpk(Sf[i].z, Sf[i].w); o1.x = cvtpk(Sb[i].x, Sb[i].y); o1.y = cvtpk(Sb[i].z, Sb[i].w);
    *(uint2*)(SBm + dv * 136 + dk0) = o0; *(uint2*)(SBm + dv * 136 + 64 + dk0) = o1;
  }
  for (int i = 0; i < 2; ++i) {
    const int tile = wid * 2 + i, m0 = (tile >> 2) * 16, n0 = (tile & 3) * 16;
    f32x4 z = {0, 0, 0, 0};
    f32x4 af = tile16(z, QA, 72, QA + 4608, 72, m0, n0, 64, lane);
    f32x4 ab = tile16(z, QA + 9216, 72, QA + 13824, 72, m0, n0, 64, lane);
    const int ti = m0 + fr; float pv[4];
#pragma unroll
    for (int j = 0; j < 4; ++j) { int tj = n0 + fq * 4 + j; pv[j] = (tj <= ti ? af[j] : 0.f) + (tj >= ti ? ab[j] : 0.f); }
    uint2 o; o.x = cvtpk(pv[0], pv[1]); o.y = cvtpk(pv[2], pv[3]);
    *(uint2*)(PL + ti * 72 + n0 + fq * 4) = o;
  }
  __syncthreads();
  f32x4 oacc[4];
#pragma unroll
  for (int i = 0; i < 4; ++i) {
    const int m0 = (wid >> 1) * 16, n0 = ((wid & 1) * 4 + i) * 16;
    f32x4 z = {0, 0, 0, 0};
    z = tile16(z, QI, 136, SBm, 136, m0, n0, 128, lane);
    oacc[i] = tile16(z, PL, 72, VT, 72, m0, n0, 64, lane);
  }
  __syncthreads();
#pragma unroll
  for (int i = 0; i < 4; ++i) {
    const int m0 = (wid >> 1) * 16, n0 = ((wid & 1) * 4 + i) * 16;
    *(float4*)(OL + (m0 + fr) * 128 + n0 + fq * 4) = *(float4*)&oacc[i];
  }
  __syncthreads();
  {
    const int t = tid >> 3, s8 = tid & 7, row = row0 + t;
    float v[16]; float ss = 0.f;
#pragma unroll
    for (int e = 0; e < 16; ++e) { v[e] = OL[t * 128 + s8 * 16 + e]; ss += v[e] * v[e]; }
    ss += __shfl_xor(ss, 1); ss += __shfl_xor(ss, 2); ss += __shfl_xor(ss, 4);
    const float rs = rsqrtf(ss * (1.f / 128.f) + 1e-6f);
    const bfu* gp = p.u + (size_t)row * NU + C_GLAG + h * 128 + s8 * 16;
    float gf[16]; unpack8(*(const uint4*)gp, gf); unpack8(*(const uint4*)(gp + 8), gf + 8);
    float o[16];
#pragma unroll
    for (int e = 0; e < 16; ++e) o[e] = v[e] * rs * p.gla_norm[l * 128 + s8 * 16 + e] * silu(gf[e]);
    bfu* mp = p.merged + (size_t)row * 4096 + 1024 + h * 128 + s8 * 16;
    *(uint4*)mp = pack8(o); *(uint4*)(mp + 8) = pack8(o + 8);
  }
  __syncthreads();
}

constexpr int QBLK = 32, KVBLK = 64;
constexpr float SCALE = 0.088388347648318440f;
constexpr float THR = 8.f;
constexpr size_t SHM_V = KVBLK * 128 * 2, SHM_K = KVBLK * 128 * 2;
#define KSWZ(row, colB) ((row) * 256 + ((colB) ^ (((row) & 7) << 4)))
#define SBAR() __builtin_amdgcn_sched_barrier(0)
__device__ __forceinline__ int crow(int r, int hi) { return (r & 3) + 8 * (r >> 2) + 4 * hi; }
__device__ __forceinline__ void partialSM(f32x16& p0, f32x16& p1, float& m_reg, float& mn, float& alpha) {
  constexpr float C = SCALE * 1.4426950408889634f;
  float pmax = p0[0]; for (int r = 1; r < 16; ++r) pmax = fmaxf(pmax, p0[r]); for (int r = 0; r < 16; ++r) pmax = fmaxf(pmax, p1[r]);
  { auto rr = __builtin_amdgcn_permlane32_swap(__float_as_uint(pmax), __float_as_uint(pmax), false, false);
    pmax = fmaxf(__uint_as_float(rr[0]), __uint_as_float(rr[1])); }
  if (__builtin_expect(__all(pmax - m_reg <= THR / SCALE), 1)) { mn = m_reg; alpha = 1.f; }
  else { mn = fmaxf(m_reg, pmax); alpha = __builtin_amdgcn_exp2f((m_reg - mn) * C); m_reg = mn; }
  float mnC = -mn * C;
  for (int r = 0; r < 16; ++r) p0[r] = fmaf(p0[r], C, mnC); for (int r = 0; r < 16; ++r) p1[r] = fmaf(p1[r], C, mnC);
  for (int r = 0; r < 16; ++r) p0[r] = __builtin_amdgcn_exp2f(p0[r]);
}
__device__ __forceinline__ void finishSM(f32x16& p0, f32x16& p1, float alpha, float& l_reg, bf16x8& pa0, bf16x8& pa1, bf16x8& pa2, bf16x8& pa3) {
  for (int r = 0; r < 16; ++r) p1[r] = __builtin_amdgcn_exp2f(p1[r]);
  float ps = 0; for (int r = 0; r < 16; ++r) ps += p0[r]; for (int r = 0; r < 16; ++r) ps += p1[r];
  { auto rr = __builtin_amdgcn_permlane32_swap(__float_as_uint(ps), __float_as_uint(ps), false, false);
    ps = __uint_as_float(rr[0]) + __uint_as_float(rr[1]); }
  l_reg = l_reg * alpha + ps;
#define PK4(P, BASE, OUT) do { unsigned a0 = cvtpk(P[BASE + 0], P[BASE + 1]), a1 = cvtpk(P[BASE + 2], P[BASE + 3]);   \
    unsigned b0 = cvtpk(P[BASE + 4], P[BASE + 5]), b1 = cvtpk(P[BASE + 6], P[BASE + 7]);                              \
    auto r0 = __builtin_amdgcn_permlane32_swap(a0, b0, false, false); auto r1 = __builtin_amdgcn_permlane32_swap(a1, b1, false, false); \
    u32x4 w = {r0[0], r1[0], r0[1], r1[1]}; OUT = *reinterpret_cast<bf16x8*>(&w); } while (0)
  PK4(p0, 0, pa0); PK4(p0, 8, pa1); PK4(p1, 0, pa2); PK4(p1, 8, pa3);
#undef PK4
}
__device__ __forceinline__ void qkt(f32x16& p0, f32x16& p1, const bf16* Ks, const bf16x8* qr, int r32, int hi) {
  p0 = f32x16{}; p1 = f32x16{};
  for (int d0 = 0; d0 < 8; ++d0) { int cb = (d0 * 16 + hi * 8) * 2;
    bf16x8 b0 = *reinterpret_cast<const bf16x8*>((const char*)Ks + KSWZ(r32, cb));
    bf16x8 b1 = *reinterpret_cast<const bf16x8*>((const char*)Ks + KSWZ(32 + r32, cb));
    p0 = __builtin_amdgcn_mfma_f32_32x32x16_bf16(b0, qr[d0], p0, 0, 0, 0);
    p1 = __builtin_amdgcn_mfma_f32_32x32x16_bf16(b1, qr[d0], p1, 0, 0, 0); }
}
__device__ __forceinline__ int v_st(int k, int c) { const int kk = (k & ~0xC) | ((k & 4) << 1) | ((k & 8) >> 1); return ((kk >> 3) * 4 + (c >> 5)) * 512 + ((kk & 7) * 32 + (c & 31)) * 2; }
__device__ __forceinline__ int v_rd_base(int lane) { return ((lane & 3) << 3) | (((lane >> 2) & 3) << 6) | (((lane >> 4) & 1) << 5) | (((lane >> 5) & 1) << 8); }
constexpr int v_rd_off(int d0, int ks, int half) { return d0 * 512 + ks * 4096 + half * 2048; }
template <int OFF> __device__ __forceinline__ s16x4 tr_read(int vb) {
  s16x4 r; asm volatile("ds_read_b64_tr_b16 %0, %1 offset:%2" : "=&v"(r) : "v"(vb), "i"(OFF) : "memory"); return r;
}
template <int D0> __device__ __forceinline__ void pv_one(f32x16& od, int vb, bf16x8 pa0, bf16x8 pa1, bf16x8 pa2, bf16x8 pa3) {
  const s16x4 l0 = tr_read<v_rd_off(D0, 0, 0)>(vb), h0 = tr_read<v_rd_off(D0, 0, 1)>(vb), l1 = tr_read<v_rd_off(D0, 1, 0)>(vb), h1 = tr_read<v_rd_off(D0, 1, 1)>(vb);
  const s16x4 l2 = tr_read<v_rd_off(D0, 2, 0)>(vb), h2 = tr_read<v_rd_off(D0, 2, 1)>(vb), l3 = tr_read<v_rd_off(D0, 3, 0)>(vb), h3 = tr_read<v_rd_off(D0, 3, 1)>(vb);
  asm volatile("s_waitcnt lgkmcnt(0)" ::: "memory"); SBAR();
#define PK(L, H) (bf16x8){L[0], L[1], L[2], L[3], H[0], H[1], H[2], H[3]}
  od = __builtin_amdgcn_mfma_f32_32x32x16_bf16(pa0, PK(l0, h0), od, 0, 0, 0);
  od = __builtin_amdgcn_mfma_f32_32x32x16_bf16(pa1, PK(l1, h1), od, 0, 0, 0);
  od = __builtin_amdgcn_mfma_f32_32x32x16_bf16(pa2, PK(l2, h2), od, 0, 0, 0);
  od = __builtin_amdgcn_mfma_f32_32x32x16_bf16(pa3, PK(l3, h3), od, 0, 0, 0);
#undef PK
}
__device__ __forceinline__ void pv_d0(f32x16* o, int vb, bf16x8 pa0, bf16x8 pa1, bf16x8 pa2, bf16x8 pa3) {
  pv_one<0>(o[0], vb, pa0, pa1, pa2, pa3); pv_one<1>(o[1], vb, pa0, pa1, pa2, pa3); pv_one<2>(o[2], vb, pa0, pa1, pa2, pa3); pv_one<3>(o[3], vb, pa0, pa1, pa2, pa3);
}

struct AttnJob {
  const bfu* Q; const bfu* K; const bfu* V;
  int NT, nctx, skip;
  int band, qpos0;
  int has_sink; float sink;
  const bfu* gate; bfu* outp;
};

__device__ __forceinline__ void attn_body(const AttnJob& J, char* lds) {
  int tid = threadIdx.x; asm volatile("" : "+v"(tid));
  const int wid = tid >> 6, lane = tid & 63, r32 = lane & 31, hi = lane >> 5;
  bf16* V_lds = (bf16*)lds; bf16* K_lds = (bf16*)(lds + 2 * SHM_V);
  float* wsm = (float*)(lds + 2 * SHM_V + 2 * SHM_K) + wid * 64; float* li_l = wsm; float* al_l = wsm + 32;
  float m_reg = -1e30f, l_reg = 0; f32x16 o[4] = {}; bf16x8 qr[8];
  const bfu* Qw = J.Q + (long)(wid * QBLK + r32) * 128 + hi * 8;
#pragma unroll
  for (int d0 = 0; d0 < 8; ++d0) qr[d0] = *reinterpret_cast<const bf16x8*>(Qw + d0 * 16);
  const int sr = tid >> 4, sc = (tid & 15) * 8, vst0 = v_st(sr, sc), vst1 = v_st(32 + sr, sc);
  const int vb0 = (int)(uintptr_t)V_lds + v_rd_base(lane);
  const bfu* Kh = J.K; const bfu* Vh = J.V;
  const int NT = J.NT, nctx = J.nctx, skip = J.skip;
  struct { bf16x8 vs0, vs1, ks0, ks1; } sr_[2];
#define KOFF(j) ((j) * KVBLK + ((j) >= nctx ? skip : 0))
#define SLOAD(i, k0) do { sr_[i].vs0 = *(const bf16x8*)(&Vh[(long)((k0) + sr) * 128 + sc]); sr_[i].vs1 = *(const bf16x8*)(&Vh[(long)((k0) + 32 + sr) * 128 + sc]); \
    sr_[i].ks0 = *(const bf16x8*)(&Kh[(long)((k0) + sr) * 128 + sc]); sr_[i].ks1 = *(const bf16x8*)(&Kh[(long)((k0) + 32 + sr) * 128 + sc]); } while (0)
#define SWRITE(b, i) do { *(bf16x8*)((char*)V_lds + (b) * SHM_V + vst0) = sr_[i].vs0;          \
    *(bf16x8*)((char*)V_lds + (b) * SHM_V + vst1) = sr_[i].vs1; int kc = sc * 2;               \
    *(bf16x8*)((char*)K_lds + (b) * SHM_K + KSWZ(sr, kc)) = sr_[i].ks0;                       \
    *(bf16x8*)((char*)K_lds + (b) * SHM_K + KSWZ(32 + sr, kc)) = sr_[i].ks1; } while (0)
#define SWAIT() asm volatile("s_waitcnt vmcnt(4)" ::: "memory")
#define RESC(a) do { if (__any((a) < 1.f)) { if (hi == 0) al_l[r32] = (a); asm volatile("s_waitcnt lgkmcnt(0)" ::: "memory"); \
    for (int d = 0; d < 4; ++d) for (int r = 0; r < 16; ++r) o[d][r] *= al_l[crow(r, hi)]; } } while (0)
#define MASK(P0, P1, j) do { if (J.band && (j) >= nctx) { const int kb = KOFF(j) - nctx * KVBLK, qw = J.qpos0 + wid * QBLK; \
    if (kb + 63 - qw > 128 || qw + 31 - kb > 128) { const int qp = qw + r32; \
      _Pragma("unroll") for (int r = 0; r < 16; ++r) { int d0_ = kb + crow(r, hi) - qp, d1_ = d0_ + 32; \
        if (d0_ > 128 || d0_ < -128) P0[r] = -1e30f; if (d1_ > 128 || d1_ < -128) P1[r] = -1e30f; } } } } while (0)
  f32x16 pA0, pA1, pB0, pB1; float mnA, mnB, alA, alB; bf16x8 pa0, pa1, pa2, pa3;
  constexpr int SE = 0, SO = 1;
  SLOAD(SE, KOFF(0)); asm volatile("s_waitcnt vmcnt(0)" ::: "memory"); SWRITE(0, SE); __syncthreads();
  qkt(pA0, pA1, K_lds, qr, r32, hi); MASK(pA0, pA1, 0); partialSM(pA0, pA1, m_reg, mnA, alA);
  SLOAD(SO, KOFF(1)); if (2 < NT) SLOAD(SE, KOFF(2));
  SWAIT(); SWRITE(1, SO); __syncthreads();
  for (int j = 1; j + 1 < NT; j += 2) {
    SBAR(); qkt(pB0, pB1, (bf16*)((char*)K_lds + SHM_K), qr, r32, hi);
    finishSM(pA0, pA1, alA, l_reg, pa0, pa1, pa2, pa3); SBAR();
    SLOAD(SO, KOFF(j + 2)); SBAR();
    pv_d0(o, vb0, pa0, pa1, pa2, pa3); MASK(pB0, pB1, j); partialSM(pB0, pB1, m_reg, mnB, alB);
    __syncthreads(); SWAIT(); SWRITE(0, SE);
    RESC(alB); __syncthreads();
    SBAR(); qkt(pA0, pA1, K_lds, qr, r32, hi);
    finishSM(pB0, pB1, alB, l_reg, pa0, pa1, pa2, pa3); SBAR();
    if (j + 3 < NT) SLOAD(SE, KOFF(j + 3)); SBAR();
    pv_d0(o, vb0 + (int)SHM_V, pa0, pa1, pa2, pa3); MASK(pA0, pA1, j + 1); partialSM(pA0, pA1, m_reg, mnA, alA);
    __syncthreads(); SWAIT(); SWRITE(1, SO);
    RESC(alA); __syncthreads();
  }
  SBAR(); qkt(pB0, pB1, (bf16*)((char*)K_lds + SHM_K), qr, r32, hi);
  finishSM(pA0, pA1, alA, l_reg, pa0, pa1, pa2, pa3); SBAR();
  pv_d0(o, vb0, pa0, pa1, pa2, pa3); MASK(pB0, pB1, NT - 1); partialSM(pB0, pB1, m_reg, mnB, alB);
  __syncthreads(); RESC(alB);
  finishSM(pB0, pB1, alB, l_reg, pa0, pa1, pa2, pa3); SBAR();
  pv_d0(o, vb0 + (int)SHM_V, pa0, pa1, pa2, pa3);
  if (J.has_sink) l_reg += __builtin_amdgcn_exp2f(J.sink * 1.4426950408889634f - m_reg * (SCALE * 1.4426950408889634f));
  if (hi == 0) li_l[r32] = l_reg; asm volatile("s_waitcnt lgkmcnt(0)" ::: "memory");
  float rli[16];
#pragma unroll
  for (int r = 0; r < 16; ++r) rli[r] = __builtin_amdgcn_rcpf(li_l[crow(r, hi)]);
  int t2 = threadIdx.x; asm volatile("" : "+v"(t2));
  const int wid2 = t2 >> 6, r32b = t2 & 31, hib = (t2 >> 5) & 1;
  bfu graw[16][4];
#pragma unroll
  for (int r = 0; r < 16; ++r) {
    const int orow = wid2 * QBLK + crow(r, hib);
#pragma unroll
    for (int d0 = 0; d0 < 4; ++d0) graw[r][d0] = J.gate[(size_t)orow * NU + d0 * 32 + r32b];
  }
#pragma unroll
  for (int r = 0; r < 16; ++r) {
    const int orow = wid2 * QBLK + crow(r, hib);
#pragma unroll
    for (int d0 = 0; d0 < 4; ++d0) {
      const float g = bf2f(graw[r][d0]);
      J.outp[(size_t)orow * 4096 + d0 * 32 + r32b] = f2bf(o[d0][r] * rli[r] * silu(g));
    }
  }
#undef SLOAD
#undef SWRITE
#undef SWAIT
#undef RESC
#undef MASK
#undef KOFF
  __syncthreads();
}

__device__ __forceinline__ void attn_job(const Params& p, int l, int a, char* lds) {
  AttnJob J;
  const int grp = a >> 7, i = a & 127;
  if (grp < 2) {
    const int type = grp == 0 ? 3 : 2, b = i >> 6, h = (i >> 3) & 7, qb = i & 7, q0 = qb * 256;
    const size_t kvoff = type == 2 ? 2097152 : 3407872;
    J.Q = p.Qb + (size_t)type * 4194304 + ((size_t)(b * 8 + h) * 2048 + q0) * 128;
    J.K = p.Kb + kvoff + (size_t)(b * 2 + (h >> 2)) * 2560 * 128; J.V = p.Vb + kvoff + (size_t)(b * 2 + (h >> 2)) * 2560 * 128;
    const int row0 = 4096 + b * 2048 + q0;
    if (type == 3) { J.NT = 40; J.nctx = 40; J.skip = 0; J.band = 0; J.qpos0 = 0; J.has_sink = 0; J.sink = 0.f;
      J.gate = p.u + (size_t)row0 * NU + C_GLBG + h * 128; J.outp = p.merged + (size_t)row0 * 4096 + 3072 + h * 128; }
    else { const int lo = max(0, q0 - 128), hiK = min(2048, q0 + 384);
      J.NT = 8 + (hiK - lo) / 64; J.nctx = 8; J.skip = lo; J.band = 1; J.qpos0 = q0; J.has_sink = 1; J.sink = p.swa_sink[l * 8 + h];
      J.gate = p.u + (size_t)row0 * NU + C_SWAG + h * 128; J.outp = p.merged + (size_t)row0 * 4096 + 2048 + h * 128; }
  } else {
    const int type = grp == 2 ? 0 : 1, b = i >> 3, h = i & 7;
    const size_t kvoff = type == 0 ? 0 : 1048576;
    J.Q = p.Qb + (size_t)type * 4194304 + (size_t)(b * 8 + h) * 256 * 128;
    J.K = p.Kb + kvoff + (size_t)(b * 2 + (h >> 2)) * 256 * 128; J.V = p.Vb + kvoff + (size_t)(b * 2 + (h >> 2)) * 256 * 128;
    const int row0 = b * 256;
    J.NT = 4; J.nctx = 4; J.skip = 0; J.band = 0; J.qpos0 = 0;
    if (type == 0) { J.has_sink = 1; J.sink = p.swa_sink[l * 8 + h];
      J.gate = p.u + (size_t)row0 * NU + C_SWAG + h * 128; J.outp = p.merged + (size_t)row0 * 4096 + 2048 + h * 128; }
    else { J.has_sink = 0; J.sink = 0.f;
      J.gate = p.u + (size_t)row0 * NU + C_GLBG + h * 128; J.outp = p.merged + (size_t)row0 * 4096 + 3072 + h * 128; }
  }
  attn_body(J, lds);
}

constexpr int M2_ATT = 512, M2_GLA = 1024, M2_LRU = 1024, M2_JOBS = M2_ATT + M2_GLA + M2_LRU;
__device__ __forceinline__ void phase_m2(const Params& p, int l, char* lds) {
  for (int bb = blockIdx.x; bb < 256; bb += gridDim.x) {
    const int natt = bb < 128 ? 1 : 3;
    for (int k = 0; k < natt; ++k) attn_job(p, l, k == 0 ? bb : 256 + (bb - 128) * 2 + (k - 1), lds);
    for (int k = 0; k < 4; ++k) { const int j = bb + 256 * k; gla_m2(p, l, j >> 3, j & 7, lds); }
    for (int k = 0; k < 4; ++k) { const int j = bb + 256 * k; lru_m2(p, l, j >> 3, j & 7); }
  }
}

#define XB_TMO      128
#define XB_XCNT(j)  (256  + 64 * (j))
#define XB_XSUB(j)  (1280 + 64 * (j))
#define XB_XGEN(j)  (2304 + 64 * (j))
#define XB_TOP      3328
#define XB_TOPGEN   3392
#define XCD_BAR_WORDS 3456
#define XB_SPIN_CAP (1u << 18)
#define LAS __attribute__((address_space(3)))
__device__ __forceinline__ unsigned xb_ld(unsigned* p)              { return __hip_atomic_load(p, __ATOMIC_RELAXED, __HIP_MEMORY_SCOPE_AGENT); }
__device__ __forceinline__ unsigned xb_add(unsigned* p, unsigned v) { return __hip_atomic_fetch_add(p, v, __ATOMIC_RELAXED, __HIP_MEMORY_SCOPE_AGENT); }
__device__ __forceinline__ unsigned xb_xcc_id() { return (unsigned)__builtin_amdgcn_s_getreg((3 << 11) | 20) & 0xFu; }
#define XB_SPIN(cond, bar) do { unsigned _sp = 0; while (cond) { __builtin_amdgcn_s_sleep(1); \
    if ((++_sp & 255u) == 0u) { if (xb_ld(&(bar)[XB_TMO])) break; if (_sp > XB_SPIN_CAP) { atomicAdd(&(bar)[XB_TMO], 1u); break; } } } } while (0)
struct XcdBarrier { unsigned* bar; unsigned x; volatile LAS unsigned* st; };
__device__ __forceinline__ XcdBarrier xcd_barrier_post(unsigned* bar, volatile LAS unsigned* st) {
  XcdBarrier b; b.bar = bar; b.x = xb_xcc_id(); b.st = st;
  if (threadIdx.x == 0) (void)xb_add(&bar[XB_XCNT(b.x)], 1u);
  return b;
}
__device__ __forceinline__ void xcd_barrier_complete(unsigned* bar, unsigned x, unsigned& nloc, unsigned& nx) {
  const unsigned G = gridDim.x * gridDim.y * gridDim.z;
  unsigned sum, cnt, mine, sp = 0u;
  for (;;) {
    sum = 0u; cnt = 0u; mine = 0u;
#pragma unroll
    for (unsigned j = 0; j < 16; ++j) { const unsigned c = xb_ld(&bar[XB_XCNT(j)]); sum += c; cnt += (c > 0u) ? 1u : 0u; mine = (j == x) ? c : mine; }
    if (sum == G) break;
    __builtin_amdgcn_s_sleep(1);
    if ((++sp & 255u) == 0u) { if (xb_ld(&bar[XB_TMO])) break; if (sp > XB_SPIN_CAP) { atomicAdd(&bar[XB_TMO], 1u); break; } }
  }
  nloc = mine > 0u ? mine : 1u; nx = cnt > 0u ? cnt : 1u;
}
__device__ __forceinline__ void xcd_barrier(const XcdBarrier& b) {
  asm volatile("s_waitcnt vmcnt(0)" ::: "memory");
  __syncthreads();
  if (threadIdx.x == 0) {
    unsigned* bar = b.bar;
    __builtin_amdgcn_s_waitcnt(0);
    unsigned nloc = b.st[0], nx = b.st[1];
    if (nloc == 0u) { xcd_barrier_complete(bar, b.x, nloc, nx); b.st[0] = nloc; b.st[1] = nx; }
    const unsigned old = xb_add(&bar[XB_XSUB(b.x)], 1u);
    const unsigned gen = old / nloc;
    if (old + 1u == (gen + 1u) * nloc) {
      __builtin_amdgcn_fence(__ATOMIC_RELEASE, "agent");
      asm volatile("s_waitcnt vmcnt(0)" ::: "memory");
      const unsigned og = xb_add(&bar[XB_TOP], 1u);
      const unsigned tg = og / nx;
      if (og + 1u == (tg + 1u) * nx) xb_add(&bar[XB_TOPGEN], 1u);
      else XB_SPIN(xb_ld(&bar[XB_TOPGEN]) == tg, bar);
      __builtin_amdgcn_fence(__ATOMIC_ACQUIRE, "agent");
      xb_add(&bar[XB_XGEN(b.x)], 1u);
      asm volatile("s_waitcnt vmcnt(0)" ::: "memory");
    } else {
      XB_SPIN(xb_ld(&bar[XB_XGEN(b.x)]) == gen, bar);
      __builtin_amdgcn_fence(__ATOMIC_ACQUIRE, "agent");
      asm volatile("s_waitcnt vmcnt(0)" ::: "memory");
    }
  }
  __syncthreads();
}

#if MULTI_LAUNCH
__global__ void __launch_bounds__(512, 2) phase_kernel(Params p, int ph) {
  char* lds = (char*)shm;
  switch (ph) {
    case 0: phase0(p, lds); break;
    case 1: phase_norm(p, 0, lds); break;
    case 2: phase_gemm_in(p, 0, lds); break;
    case 3: phase_m1(p, 0, lds); break;
    case 4: phase_m2(p, 0, lds); break;
    case 5: phase_gemm_out(p, 0); break;
    case 6: phase_norm(p, 1, lds); break;
    case 7: phase_gemm_in(p, 1, lds); break;
    case 8: phase_m1(p, 1, lds); break;
    case 9: phase_m2(p, 1, lds); break;
    case 10: phase_gemm_out(p, 1); break;
    case 11: phase_norm(p, 2, lds); break;
  }
}
#else
__global__ void __launch_bounds__(512, 2) mega_kernel(Params p) {
  cg::grid_group grid = cg::this_grid();
  char* lds = (char*)shm;
  volatile LAS unsigned* st = (volatile LAS unsigned*)((LAS char*)shm + SHM_BYTES);
  if (threadIdx.x == 0) { st[0] = 0u; st[1] = 0u; }
  XcdBarrier xb = xcd_barrier_post(p.bar, st);
  if (p.never) grid.sync();
  phase0(p, lds); xcd_barrier(xb);
  phase_norm(p, 0, lds); xcd_barrier(xb);
  phase_gemm_in(p, 0, lds); xcd_barrier(xb);
  phase_m1(p, 0, lds); xcd_barrier(xb);
  phase_m2(p, 0, lds); xcd_barrier(xb);
  phase_gemm_out(p, 0); xcd_barrier(xb);
  phase_norm(p, 1, lds); xcd_barrier(xb);
  phase_gemm_in(p, 1, lds); xcd_barrier(xb);
  phase_m1(p, 1, lds); xcd_barrier(xb);
  phase_m2(p, 1, lds); xcd_barrier(xb);
  phase_gemm_out(p, 1); xcd_barrier(xb);
  phase_norm(p, 2, lds);
}
#endif

static size_t al256(size_t x) { return (x + 255) / 256 * 256; }

extern "C" void kernel_launch(void* const* d_in, const int* in_sizes, int n_in, void* d_out, int out_size, void* d_ws, size_t ws_size,
                              hipStream_t stream) {
  Params p{};
  const float** pf = (const float**)&p;
  for (int i = 0; i < 29; ++i) pf[i] = (const float*)d_in[i];
  p.out = (float*)d_out;
  char* w = (char*)d_ws; size_t off = 0;
  auto take = [&](size_t bytes) { char* r = w + off; off = al256(off + bytes); return r; };
  p.WinT = (bfu*)take((size_t)2 * NG * 4096 * 2);
  p.WlrT = (bfu*)take((size_t)2 * 32 * 4096 * 2);
  p.WoutT = (bfu*)take((size_t)2 * 4096 * 4096 * 2);
  p.WgT = (bfu*)take((size_t)64 * 16384 * 2);
  p.hbuf = (bfu*)take((size_t)NTOK * 4096 * 2);
  p.u = (bfu*)take((size_t)NTOK * NU * 2);
  p.merged = (bfu*)take((size_t)NTOK * 4096 * 2);
  p.Qb = (bfu*)take((size_t)4 * 4194304 * 2);
  p.Kb = (bfu*)take((size_t)4718592 * 2);
  p.Vb = (bfu*)take((size_t)4718592 * 2);
  p.modv = (float*)take((size_t)6 * 12288 * 4);
  p.rope = (float*)take((size_t)2048 * 128 * 4);
  p.xbuf = (bfu*)take((size_t)NTOK * 4096 * 2);
  p.scan = (bfu*)take((size_t)4 * 8388608 * 2);
  p.lsum = (float*)take((size_t)2 * 128 * 1024 * 2 * 4);
  p.kv = (float*)take((size_t)128 * 8 * 2 * 8192 * 4);
  p.dec = (float*)take((size_t)128 * 8 * 2 * 64 * 4);
  p.sp8 = (float*)take((size_t)4096 * 4);
  p.ctr = (unsigned*)take(256);
  p.bar = (unsigned*)take((size_t)XCD_BAR_WORDS * 4);
  if (off > ws_size || n_in != 29) { fprintf(stderr, "kernel_launch: ws too small (%zu > %zu) or n_in %d\n", off, ws_size, n_in); return; }
#if MULTI_LAUNCH
  static int init = 0;
  if (!init) { hipFuncSetAttribute((const void*)phase_kernel, hipFuncAttributeMaxDynamicSharedMemorySize, SHM_BYTES); init = 1; }
  for (int ph = 0; ph < 12; ++ph) hipLaunchKernelGGL(phase_kernel, dim3(256), dim3(512), SHM_BYTES, stream, p, ph);
#else
  static int grid_blocks = 0;
  if (!grid_blocks) {
    hipFuncSetAttribute((const void*)mega_kernel, hipFuncAttributeMaxDynamicSharedMemorySize, SHM_TOTAL);
    int dev = 0, cus = 0, per_cu = 0;
    hipGetDevice(&dev);
    hipDeviceGetAttribute(&cus, hipDeviceAttributeMultiprocessorCount, dev);
    hipOccupancyMaxActiveBlocksPerMultiprocessor(&per_cu, mega_kernel, 512, SHM_TOTAL);
    if (per_cu > 1) per_cu = 1;
    grid_blocks = cus * per_cu;
    if (grid_blocks <= 0) { fprintf(stderr, "occupancy query failed\n"); grid_blocks = 0; return; }
  }
  void* args[] = {&p};
  (void)hipMemsetAsync(p.bar, 0, (size_t)XCD_BAR_WORDS * 4, stream);
  hipError_t e = hipLaunchCooperativeKernel((void*)mega_kernel, dim3(grid_blocks), dim3(512), args, SHM_TOTAL, stream);
  if (e != hipSuccess) fprintf(stderr, "cooperative launch failed: %s (grid %d)\n", hipGetErrorString(e), grid_blocks);
#endif
}
```

```cpp
#include <hip/hip_runtime.h>
#include <hip/hip_bf16.h>
#include <hip/hip_cooperative_groups.h>
#include <cstdio>
namespace cg = cooperative_groups;

#ifndef MULTI_LAUNCH
#define MULTI_LAUNCH 0
#endif

typedef unsigned short bfu;
using bf16 = __hip_bfloat16;
using bf16x8 = __attribute__((ext_vector_type(8))) short;
using s16x4 = __attribute__((ext_vector_type(4))) short;
using f32x4 = __attribute__((ext_vector_type(4))) float;
using f32x16 = __attribute__((ext_vector_type(16))) float;
using u32x4 = __attribute__((ext_vector_type(4))) unsigned;

constexpr int DM = 4096, NTOK = 8192, NU = 10272, NG = 10240;
constexpr int C_LRUX = 0, C_LRUG = 1024, C_GLAQ = 2048, C_GLAK = 2560, C_GLAV = 3072, C_GLAG = 4096, C_SWAQ = 5120, C_SWAK = 6144,
              C_SWAV = 6400, C_SWAG = 6656, C_GLBQ = 7680, C_GLBK = 8704, C_GLBV = 8960, C_GLBG = 9216, C_LR = 10240;
constexpr size_t OUT_Y = 0, OUT_LRU = 33554432, OUT_GLA = 33619968, OUT_CACHE = 37814272;
constexpr int SHM_BYTES = 131072;
constexpr int SHM_TOTAL = SHM_BYTES + 256;

struct Params {
  const float *x_prompt, *x_sample, *c, *state_lru, *state_gla, *cswk, *cswv, *cglk, *cglv, *c_ctx, *norm_w, *w_mod, *b_mod, *w_in,
      *conv_w, *conv_b, *lru_wa, *lru_ba, *lru_wx, *lru_bx, *lru_lam, *gla_wup, *gla_bup, *gla_norm, *swa_sink, *qnorm, *knorm, *w_out, *final_norm;
  float* out;
  bfu *WinT, *WlrT, *WoutT, *WgT, *hbuf, *u, *merged, *Qb, *Kb, *Vb;
  float *modv, *rope, *lsum, *kv, *dec;
  bfu* scan;
  bfu* xbuf;
  float* sp8;
  unsigned* ctr;
  unsigned* bar;
  long never;
};

extern __shared__ __attribute__((aligned(16))) bf16 shm[];

template <typename T> __device__ __forceinline__ T opq(T x) { asm volatile("" : "+s"(x)); return x; }
__device__ __forceinline__ int otid() { int t = threadIdx.x; asm volatile("" : "+v"(t)); return t; }
__device__ __forceinline__ float bf2f(bfu h) { return __uint_as_float(((unsigned)h) << 16); }
__device__ __forceinline__ unsigned cvtpk(float lo, float hi) {
  unsigned r; asm volatile("v_cvt_pk_bf16_f32 %0, %1, %2" : "=v"(r) : "v"(lo), "v"(hi)); return r;
}
__device__ __forceinline__ bfu f2bf(float f) { return (bfu)(cvtpk(f, 0.f) & 0xffffu); }
__device__ __forceinline__ float f4get(float4 v, int j) { return j == 0 ? v.x : (j == 1 ? v.y : (j == 2 ? v.z : v.w)); }
__device__ __forceinline__ float silu(float v) { return v * __builtin_amdgcn_rcpf(1.f + __expf(-v)); }
__device__ __forceinline__ float sigmoidf(float v) { return 1.f / (1.f + __expf(-v)); }
__device__ __forceinline__ float wave_sum(float v) {
#pragma unroll
  for (int o = 32; o; o >>= 1) v += __shfl_xor(v, o);
  return v;
}
__device__ __forceinline__ void unpack8(uint4 v, float* f) {
  f[0] = __uint_as_float(v.x << 16); f[1] = __uint_as_float(v.x & 0xffff0000u);
  f[2] = __uint_as_float(v.y << 16); f[3] = __uint_as_float(v.y & 0xffff0000u);
  f[4] = __uint_as_float(v.z << 16); f[5] = __uint_as_float(v.z & 0xffff0000u);
  f[6] = __uint_as_float(v.w << 16); f[7] = __uint_as_float(v.w & 0xffff0000u);
}
__device__ __forceinline__ uint4 pack8(const float* f) {
  uint4 r; r.x = cvtpk(f[0], f[1]); r.y = cvtpk(f[2], f[3]); r.z = cvtpk(f[4], f[5]); r.w = cvtpk(f[6], f[7]); return r;
}
__device__ __forceinline__ f32x4 tile16(f32x4 acc, const bfu* A, int lda, const bfu* B, int ldb, int m0, int n0, int K, int lane) {
  const int fr = lane & 15, fq = lane >> 4;
  for (int k0 = 0; k0 < K; k0 += 32) {
    bf16x8 a = *reinterpret_cast<const bf16x8*>(A + (m0 + fr) * lda + k0 + fq * 8);
    bf16x8 b = *reinterpret_cast<const bf16x8*>(B + (n0 + fr) * ldb + k0 + fq * 8);
    acc = __builtin_amdgcn_mfma_f32_16x16x32_bf16(b, a, acc, 0, 0, 0);
  }
  return acc;
}

__device__ __forceinline__ void p0_gemv(const Params& p, int job, char* lds) {
  const int l = job >> 7, j0 = (job & 127) * 96, tid = otid();
  float* sv = (float*)lds;
  const float* cctx = opq(p.c_ctx); const float* clat = opq(p.c);
  for (int i = tid; i < 3 * 4096; i += 512) {
    int r = i >> 12, k = i & 4095;
    float v = (r == 0) ? cctx[k] : clat[(r - 1) * 4096 + k];
    sv[i] = v / (1.f + expf(-v));
  }
  __syncthreads();
  float a00 = 0, a01 = 0, a02 = 0, a03 = 0, a10 = 0, a11 = 0, a12 = 0, a13 = 0, a20 = 0, a21 = 0, a22 = 0, a23 = 0;
  const int cl = tid % 24, rl = tid / 24;
  if (rl < 21) {
    const float* W = p.w_mod + (size_t)l * 4096 * 12288 + j0 + cl * 4;
#pragma unroll 8
    for (int k = rl; k < 4096; k += 21) {
      float4 w = *(const float4*)(W + (size_t)k * 12288);
      float s0 = sv[k], s1 = sv[4096 + k], s2 = sv[8192 + k];
      a00 += s0 * w.x; a01 += s0 * w.y; a02 += s0 * w.z; a03 += s0 * w.w;
      a10 += s1 * w.x; a11 += s1 * w.y; a12 += s1 * w.z; a13 += s1 * w.w;
      a20 += s2 * w.x; a21 += s2 * w.y; a22 += s2 * w.z; a23 += s2 * w.w;
    }
  }
  float* red = (float*)(lds + 49152);
  if (rl < 21) {
    float* r0 = red + (rl * 3) * 96 + cl * 4;
    r0[0] = a00; r0[1] = a01; r0[2] = a02; r0[3] = a03;
    r0[96] = a10; r0[97] = a11; r0[98] = a12; r0[99] = a13;
    r0[192] = a20; r0[193] = a21; r0[194] = a22; r0[195] = a23;
  }
  __syncthreads();
  if (tid < 288) {
    int r = tid / 96, j = tid % 96; float s = 0;
    for (int q = 0; q < 21; ++q) s += red[(q * 3 + r) * 96 + j];
    p.modv[(l * 3 + r) * 12288 + j0 + j] = s + p.b_mod[l * 12288 + j0 + j];
  }
  __syncthreads();
}

struct TUnit { const float* src; size_t ldsrc; int k0; bfu* dst; };
__device__ __forceinline__ TUnit p0_unit(const Params& p, int j) {
  TUnit u;
  const float* win = opq(p.w_in); const float* wout = opq(p.w_out); bfu* WinT = opq(p.WinT); bfu* WlrT = opq(p.WlrT); bfu* WoutT = opq(p.WoutT);
  if (j < 2 * 8 * 321) {
    int l = j / (8 * 321), r = j % (8 * 321), kb = r / 321, nt = r % 321, nsrc0 = nt * 32;
    if (nsrc0 < 4096) u.dst = WinT + (size_t)l * NG * 4096 + (size_t)nsrc0 * 4096;
    else if (nsrc0 < 4128) u.dst = WlrT + (size_t)l * 32 * 4096;
    else u.dst = WinT + (size_t)l * NG * 4096 + (size_t)(nsrc0 - 32) * 4096;
    u.src = win + (size_t)l * 4096 * NU + nsrc0; u.ldsrc = NU; u.k0 = kb * 512;
  } else {
    j -= 2 * 8 * 321;
    int l = j / (8 * 128), r = j % (8 * 128), kb = r / 128, nt = r % 128, nsrc0 = nt * 32;
    u.dst = WoutT + (size_t)l * 4096 * 4096 + (size_t)nsrc0 * 4096;
    u.src = wout + (size_t)l * 4096 * 4096 + nsrc0; u.ldsrc = 4096; u.k0 = kb * 512;
  }
  return u;
}
__device__ __forceinline__ void p0_tload(const TUnit& u, int tid, float4* v) {
  const int c4 = tid & 7, r0 = tid >> 3;
#pragma unroll
  for (int i = 0; i < 8; ++i) v[i] = *(const float4*)(u.src + (size_t)(u.k0 + r0 + 64 * i) * u.ldsrc + c4 * 4);
}
__device__ __forceinline__ void p0_tstore(const TUnit& u, int tid, const float4* v, char* lds) {
  bfu* T = (bfu*)lds;
  const int c4 = tid & 7, r0 = tid >> 3;
#pragma unroll
  for (int i = 0; i < 8; ++i) {
    const int k = r0 + 64 * i, ks = (((k >> 3) ^ c4) << 3) | (k & 7);
    T[(c4 * 4 + 0) * 520 + ks] = f2bf(v[i].x); T[(c4 * 4 + 1) * 520 + ks] = f2bf(v[i].y);
    T[(c4 * 4 + 2) * 520 + ks] = f2bf(v[i].z); T[(c4 * 4 + 3) * 520 + ks] = f2bf(v[i].w);
  }
  __syncthreads();
#pragma unroll
  for (int i = 0; i < 4; ++i) {
    int id = tid + 512 * i, n = id >> 6, kc = id & 63;
    uint4 val = *(const uint4*)(T + n * 520 + ((kc ^ (n >> 2)) << 3));
    *(uint4*)(u.dst + (size_t)n * 4096 + u.k0 + kc * 8) = val;
  }
  __syncthreads();
}
__device__ __forceinline__ void p0_transposes(const Params& p, char* lds) {
  const int tid = otid(); constexpr int NUNIT = 2 * 8 * 321 + 2 * 8 * 128;
  int j = blockIdx.x;
  if (j >= NUNIT) return;
  float4 va[8], vb[8];
  TUnit ua = p0_unit(p, j), ub = ua;
  p0_tload(ua, tid, va);
  for (;;) {
    int jn = j + gridDim.x; bool hb = jn < NUNIT;
    if (hb) { ub = p0_unit(p, jn); p0_tload(ub, tid, vb); }
    p0_tstore(ua, tid, va, lds);
    if (!hb) break;
    j = jn + gridDim.x; bool ha = j < NUNIT;
    if (ha) { ua = p0_unit(p, j); p0_tload(ua, tid, va); }
    p0_tstore(ub, tid, vb, lds);
    if (!ha) break;
  }
}

constexpr int P0_GEMV = 256, P0_TIN = 2 * 8 * 321, P0_TOUT = 2 * 8 * 128, P0_WG = 64, P0_ROPE = 256, P0_SP = 8;
constexpr int P0_JOBS = P0_GEMV + P0_TIN + P0_TOUT + P0_WG + P0_ROPE + P0_SP;

__device__ __forceinline__ void phase0(const Params& p, char* lds) {
  if (blockIdx.x == 0 && threadIdx.x < 16) p.ctr[threadIdx.x] = 0;
  for (int job = blockIdx.x; job < P0_JOBS; job += gridDim.x) {
    int j = job;
    if (j < P0_GEMV) { p0_gemv(p, j, lds); continue; }
    j -= P0_GEMV;
    if (j < P0_TIN + P0_TOUT) continue;
    j -= P0_TIN + P0_TOUT;
    if (j < P0_WG) {
      int l = j >> 5, m = (j >> 3) & 3, hb = j & 7, d = m >> 1;
      const float* wxp = opq(p.lru_wx); const float* wap = opq(p.lru_wa);
      const float* src = ((m & 1) ? wxp : wap) + (size_t)((l * 2 + d) * 8 + hb) * 16384;
      bfu* dst = p.WgT + (size_t)j * 16384;
      for (int idx = otid(); idx < 16384; idx += 512) { int jj = idx >> 7, ii = idx & 127; dst[idx] = f2bf(src[ii * 128 + jj]); }
      continue;
    }
    j -= P0_WG;
    if (j >= P0_ROPE) {
      const int e = (j - P0_ROPE) * 512 + otid();
      const float nl = -p.lru_lam[e];
      p.sp8[e] = -8.f * (fmaxf(nl, 0.f) + log1pf(expf(-fabsf(nl))));
      continue;
    }
    {
      int e = j * 512 + otid(), t = e >> 6, a = (e >> 5) & 1, c = e & 31;
      float pos = (float)(a == 0 ? (t >> 6) : (t & 63));
      float inv = powf(10000.f, -(float)c / 32.f);
      float sn, cs; sincosf(pos * inv, &sn, &cs);
      p.rope[e * 2] = cs; p.rope[e * 2 + 1] = sn;
    }
  }
  p0_transposes(p, lds);
}

__device__ __forceinline__ const float* xrow_ptr(const Params& p, int row) {
  const float* xp = opq(p.x_prompt); const float* xs = opq(p.x_sample);
  return row < 4096 ? xp + (size_t)row * 4096 : xs + (size_t)(row - 4096) * 4096;
}
__device__ __forceinline__ void phase_norm(const Params& p, int l, char* lds) {
  float* WA = (float*)lds;
  float* WB = (float*)(lds + 16384);
  for (int rb = blockIdx.x; rb < 256; rb += gridDim.x) {
    const int tid = otid(), wid = tid >> 6, lane = tid & 63;
    const int row0 = rb * 32, cond = row0 < 4096 ? 0 : (row0 < 6144 ? 1 : 2);
    __syncthreads();
    if (l != 2) {
      const float* mv = p.modv + (l * 3 + cond) * 12288;
      for (int i = tid; i < 1024; i += 512) {
        const float4 w = *(const float4*)(p.norm_w + l * 4096 + i * 4), sh = *(const float4*)(mv + i * 4), sc = *(const float4*)(mv + 4096 + i * 4);
        *(float4*)(WA + i * 4) = make_float4(w.x * (1.f + sc.x), w.y * (1.f + sc.y), w.z * (1.f + sc.z), w.w * (1.f + sc.w));
        *(float4*)(WB + i * 4) = sh;
      }
    }
    __syncthreads();
#pragma unroll 1
    for (int i = 0; i < 4; ++i) {
      const int row = row0 + wid * 4 + i;
      float4 v[16]; float ss = 0;
      if (l == 0) {
        const float* xr = xrow_ptr(p, row);
#pragma unroll
        for (int q = 0; q < 16; ++q) v[q] = ((const float4*)xr)[lane + 64 * q];
      } else {
        const uint4* xr = (const uint4*)(p.xbuf + (size_t)row * 4096);
#pragma unroll
        for (int q2 = 0; q2 < 8; ++q2) {
          float t8[8]; unpack8(xr[lane + 64 * q2], t8);
          v[2 * q2] = make_float4(t8[0], t8[1], t8[2], t8[3]); v[2 * q2 + 1] = make_float4(t8[4], t8[5], t8[6], t8[7]);
        }
      }
#pragma unroll
      for (int q = 0; q < 16; ++q) ss += v[q].x * v[q].x + v[q].y * v[q].y + v[q].z * v[q].z + v[q].w * v[q].w;
      ss = wave_sum(ss);
#define NCOL(q) (l == 0 ? (lane + 64 * (q)) * 4 : (lane + 64 * ((q) >> 1)) * 8 + ((q) & 1) * 4)
      const float rs = rsqrtf(ss * (1.f / 4096.f) + 1e-6f);
      if (l == 2) {
        float4 wv[16];
#pragma unroll
        for (int q = 0; q < 16; ++q) wv[q] = *(const float4*)(p.final_norm + NCOL(q));
#pragma unroll
        for (int q = 0; q < 16; ++q) {
          const int col = NCOL(q); const float4 w = wv[q];
          *(float4*)(p.out + OUT_Y + (size_t)row * 4096 + col) = make_float4(v[q].x * rs * w.x, v[q].y * rs * w.y, v[q].z * rs * w.z, v[q].w * rs * w.w);
        }
      } else {
#pragma unroll
        for (int q = 0; q < 16; ++q) {
          const int col = NCOL(q); const float4 a = *(const float4*)(WA + col), b = *(const float4*)(WB + col);
          uint2 o; o.x = cvtpk(v[q].x * rs * a.x + b.x, v[q].y * rs * a.y + b.y); o.y = cvtpk(v[q].z * rs * a.z + b.z, v[q].w * rs * a.w + b.w);
          *(uint2*)(p.hbuf + (size_t)row * 4096 + col) = o;
        }
      }
#undef NCOL
    }
  }
}

constexpr int BM = 256, BK = 64, HALF = 128, NXCD = 8, WGM = 8, HT = HALF * BK;
__device__ __forceinline__ int lds_byte(int r, int c) {
  int st = (r >> 4) * 2 + (c >> 5), rr = r & 15, cc = c & 31, ob = rr * 64 + cc * 2;
  return st * 1024 + (ob ^ (((ob >> 9) & 1) << 5));
}
__device__ __forceinline__ void stage_rc(int b, int& R, int& C) {
  int st = b / 1024, sb = b % 1024, swz = sb ^ (((sb >> 9) & 1) << 5);
  R = (st >> 1) * 16 + swz / 64; C = (st & 1) * 32 + (swz % 64) / 2;
}

template <int MODE>
__device__ __forceinline__ void gemm_tile(const Params& p, int l, const bf16* __restrict__ A, const bf16* __restrict__ Bt, int nN, int wgid) {
  constexpr int K = 4096;
#define SA(b, h) (shm + ((b) * 2 + (h)) * HT)
#define SB(b, h) (shm + (4 + (b) * 2 + (h)) * HT)
#define STAGE(P, BASE, br, kt) do { long _g = (long)(br) * K + (long)(kt) * BK; \
    for (int _i = 0; _i < 2; ++_i) { int _b = tx * 16 + _i * 8192; int _r, _c; stage_rc(_b, _r, _c); \
      __builtin_amdgcn_global_load_lds((const unsigned*)(BASE + _g + (long)_r * K + _c), \
        (unsigned*)((char*)(P) + _b), 16, 0, 0); } } while (0)
#define LDA(dst, b, h) for (int m = 0; m < 4; ++m) for (int k = 0; k < 2; ++k) \
    dst[m][k] = *reinterpret_cast<const bf16x8*>((char*)SA(b, h) + lds_byte(wr * 64 + m * 16 + fr, k * 32 + fq * 8))
#define LDB(dst, b, h) for (int n = 0; n < 2; ++n) for (int k = 0; k < 2; ++k) \
    dst[n][k] = *reinterpret_cast<const bf16x8*>((char*)SB(b, h) + lds_byte(wc * 32 + n * 16 + fr, k * 32 + fq * 8))
#define MMA(ai, bj, At, Bt_) do { __builtin_amdgcn_s_setprio(1); \
    for (int m = 0; m < 4; ++m) for (int n = 0; n < 2; ++n) for (int k = 0; k < 2; ++k) \
      acc[ai][bj][m][n] = __builtin_amdgcn_mfma_f32_16x16x32_bf16(Bt_[n][k], At[m][k], acc[ai][bj][m][n], 0, 0, 0); \
    __builtin_amdgcn_s_setprio(0); } while (0)
#define WAIT_V(n) asm volatile("s_waitcnt vmcnt(" #n ")" ::: "memory")
#define WAIT_L(n) asm volatile("s_waitcnt lgkmcnt(" #n ")" ::: "memory")
#define BAR __builtin_amdgcn_s_barrier()
#define SCHED __builtin_amdgcn_sched_barrier(0)
  const int nM = 32, nwg = nM * nN;
  {
    int q = nwg / NXCD, r = nwg % NXCD, xcd = wgid % NXCD, off = wgid / NXCD;
    wgid = (xcd < r ? xcd * (q + 1) : r * (q + 1) + (xcd - r) * q) + off;
  }
  int nig = WGM * nN, gid = wgid / nig, fm = gid * WGM, gsz = min(nM - fm, WGM);
  int pm = fm + ((wgid % nig) % gsz), pn = (wgid % nig) / gsz, brow = pm * BM, bcol = pn * BM;
  int tx = threadIdx.x; asm volatile("" : "+v"(tx));
  int wid = __builtin_amdgcn_readfirstlane(tx >> 6), lane = tx & 63, wr = wid >> 2, wc = wid & 3, fr = lane & 15, fq = lane >> 4;
  f32x4 acc[2][2][4][2] = {};
  bf16x8 At[4][2], B0[2][2], B1[2][2];
  const int nt = K / BK;
  STAGE(SB(0, 0), Bt, bcol, 0); STAGE(SA(0, 0), A, brow, 0);
  STAGE(SB(0, 1), Bt, bcol + HALF, 0); STAGE(SA(0, 1), A, brow + HALF, 0);
  if (wr == 1) BAR;
  WAIT_V(4); BAR;
  STAGE(SB(1, 0), Bt, bcol, 1); STAGE(SA(1, 0), A, brow, 1); STAGE(SB(1, 1), Bt, bcol + HALF, 1);
  WAIT_V(6); BAR;
  for (int t = 0; t < nt - 2; t += 2) {
    LDB(B0, 0, 0); SCHED; LDA(At, 0, 0); STAGE(SA(1, 1), A, brow + HALF, t + 1);
    WAIT_L(8); BAR; WAIT_L(0); MMA(0, 0, At, B0); BAR; SCHED;
    LDB(B1, 0, 1); STAGE(SB(0, 0), Bt, bcol, t + 2);
    BAR; WAIT_L(0); MMA(0, 1, At, B1); BAR;
    LDA(At, 0, 1); STAGE(SA(0, 0), A, brow, t + 2);
    BAR; WAIT_L(0); MMA(1, 0, At, B0); BAR; SCHED;
    STAGE(SB(0, 1), Bt, bcol + HALF, t + 2);
    WAIT_V(6); BAR; MMA(1, 1, At, B1); BAR;
    LDB(B0, 1, 0); SCHED; LDA(At, 1, 0); STAGE(SA(0, 1), A, brow + HALF, t + 2);
    WAIT_L(8); BAR; WAIT_L(0); MMA(0, 0, At, B0); BAR; SCHED;
    LDB(B1, 1, 1); STAGE(SB(1, 0), Bt, bcol, t + 3);
    BAR; WAIT_L(0); MMA(0, 1, At, B1); BAR;
    LDA(At, 1, 1); STAGE(SA(1, 0), A, brow, t + 3);
    BAR; WAIT_L(0); MMA(1, 0, At, B0); BAR; SCHED;
    STAGE(SB(1, 1), Bt, bcol + HALF, t + 3);
    WAIT_V(6); BAR; MMA(1, 1, At, B1); BAR;
  }
  { LDB(B0, 0, 0); LDA(At, 0, 0); STAGE(SA(1, 1), A, brow + HALF, nt - 1);
    BAR; WAIT_L(0); MMA(0, 0, At, B0); BAR;
    LDB(B1, 0, 1); BAR; WAIT_L(0); MMA(0, 1, At, B1); BAR;
    LDA(At, 0, 1); WAIT_V(4); BAR; WAIT_L(0); MMA(1, 0, At, B0); MMA(1, 1, At, B1); BAR; }
  { LDB(B0, 1, 0); LDA(At, 1, 0); WAIT_V(2); BAR; WAIT_L(0); MMA(0, 0, At, B0); BAR;
    LDB(B1, 1, 1); WAIT_V(0); BAR; WAIT_L(0); MMA(0, 1, At, B1); BAR;
    LDA(At, 1, 1); BAR; WAIT_L(0); MMA(1, 0, At, B0); MMA(1, 1, At, B1); BAR; }
  if (wr == 0) BAR;
  int tx2 = threadIdx.x; asm volatile("" : "+v"(tx2));
  wid = __builtin_amdgcn_readfirstlane(tx2 >> 6); lane = tx2 & 63; wr = wid >> 2; wc = wid & 3; fr = lane & 15; fq = lane >> 4;
  if (MODE == 0) {
#pragma unroll
    for (int ai = 0; ai < 2; ++ai)
#pragma unroll
      for (int m = 0; m < 4; ++m) {
        const int row = brow + ai * HALF + wr * 64 + m * 16 + fr;
#pragma unroll
        for (int bj = 0; bj < 2; ++bj) {
          const f32x4 a0 = acc[ai][bj][m][0], a1 = acc[ai][bj][m][1];
          uint2 o0, o1; o0.x = cvtpk(a0[0], a0[1]); o0.y = cvtpk(a0[2], a0[3]); o1.x = cvtpk(a1[0], a1[1]); o1.y = cvtpk(a1[2], a1[3]);
          const bool odd = fq & 1;
          const unsigned sx = odd ? o0.x : o1.x, sy = odd ? o0.y : o1.y;
          const unsigned rx = (unsigned)__shfl_xor((int)sx, 16), ry = (unsigned)__shfl_xor((int)sy, 16);
          uint4 o; int col;
          if (!odd) { o = make_uint4(o0.x, o0.y, rx, ry); col = bcol + bj * HALF + wc * 32 + fq * 4; }
          else { o = make_uint4(rx, ry, o1.x, o1.y); col = bcol + bj * HALF + wc * 32 + 16 + (fq - 1) * 4; }
          *(uint4*)(p.u + (size_t)row * NU + col) = o;
        }
      }
  } else {
    const int cond = brow < 4096 ? 0 : (brow < 6144 ? 1 : 2);
    float4 g[2][2];
#pragma unroll
    for (int bj = 0; bj < 2; ++bj)
#pragma unroll
      for (int n = 0; n < 2; ++n) g[bj][n] = *(const float4*)(p.modv + (l * 3 + cond) * 12288 + 8192 + bcol + bj * HALF + wc * 32 + n * 16 + fq * 4);
#pragma unroll
    for (int ai = 0; ai < 2; ++ai) {
      float4 xo[4][2][2];
#pragma unroll
      for (int m = 0; m < 4; ++m) {
        const int row = brow + ai * HALF + wr * 64 + m * 16 + fr;
        if (l == 0) {
          const float* xr = xrow_ptr(p, row);
#pragma unroll
          for (int bj = 0; bj < 2; ++bj)
#pragma unroll
            for (int n = 0; n < 2; ++n) xo[m][bj][n] = *(const float4*)(xr + bcol + bj * HALF + wc * 32 + n * 16 + fq * 4);
        } else {
          const bfu* xr = p.xbuf + (size_t)row * 4096;
#pragma unroll
          for (int bj = 0; bj < 2; ++bj)
#pragma unroll
            for (int n = 0; n < 2; ++n) {
              const uint2 r = *(const uint2*)(xr + bcol + bj * HALF + wc * 32 + n * 16 + fq * 4);
              xo[m][bj][n] = make_float4(__uint_as_float(r.x << 16), __uint_as_float(r.x & 0xffff0000u), __uint_as_float(r.y << 16), __uint_as_float(r.y & 0xffff0000u));
            }
        }
      }
#pragma unroll
      for (int m = 0; m < 4; ++m) {
        const int row = brow + ai * HALF + wr * 64 + m * 16 + fr;
#pragma unroll
        for (int bj = 0; bj < 2; ++bj)
#pragma unroll
          for (int n = 0; n < 2; ++n) {
            const int col = bcol + bj * HALF + wc * 32 + n * 16 + fq * 4;
            const f32x4 a = acc[ai][bj][m][n]; const float4 x4 = xo[m][bj][n], g4 = g[bj][n];
            uint2 o; o.x = cvtpk(x4.x + g4.x * a[0], x4.y + g4.y * a[1]); o.y = cvtpk(x4.z + g4.z * a[2], x4.w + g4.w * a[3]);
            *(uint2*)(p.xbuf + (size_t)row * 4096 + col) = o;
          }
      }
    }
  }
  __syncthreads();
#undef SA
#undef SB
#undef STAGE
#undef LDA
#undef LDB
#undef MMA
}

__device__ __forceinline__ void lr_tile(const Params& p, int l, int rb, char* lds) {
  const int tid = otid(), w = tid >> 6, lane = tid & 63, fr = lane & 15, fq = lane >> 4, row0 = rb * 32;
  const bfu* A = p.hbuf + (size_t)row0 * 4096; const bfu* B = p.WlrT + (size_t)l * 32 * 4096;
  f32x4 acc[2][2] = {};
  for (int k0 = w * 512; k0 < w * 512 + 512; k0 += 128) {
    bf16x8 a[4][2], b[4][2];
#pragma unroll
    for (int s4 = 0; s4 < 4; ++s4)
#pragma unroll
      for (int i = 0; i < 2; ++i) {
        a[s4][i] = *reinterpret_cast<const bf16x8*>(A + (size_t)(i * 16 + fr) * 4096 + k0 + s4 * 32 + fq * 8);
        b[s4][i] = *reinterpret_cast<const bf16x8*>(B + (size_t)(i * 16 + fr) * 4096 + k0 + s4 * 32 + fq * 8);
      }
#pragma unroll
    for (int s4 = 0; s4 < 4; ++s4)
#pragma unroll
      for (int mi = 0; mi < 2; ++mi)
#pragma unroll
        for (int ni = 0; ni < 2; ++ni)
          acc[mi][ni] = __builtin_amdgcn_mfma_f32_16x16x32_bf16(b[s4][ni], a[s4][mi], acc[mi][ni], 0, 0, 0);
  }
  float* red = (float*)lds;
#pragma unroll
  for (int mi = 0; mi < 2; ++mi)
#pragma unroll
    for (int ni = 0; ni < 2; ++ni)
#pragma unroll
      for (int j = 0; j < 4; ++j)
        red[w * 1024 + (mi * 16 + fr) * 32 + ni * 16 + fq * 4 + j] = acc[mi][ni][j];
  __syncthreads();
  for (int e = tid; e < 1024; e += 512) {
    float s = 0;
    for (int q = 0; q < 8; ++q) s += red[q * 1024 + e];
    p.u[(size_t)(row0 + (e >> 5)) * NU + C_LR + (e & 31)] = f2bf(s);
  }
  __syncthreads();
}

__device__ __forceinline__ void phase_gemm_in(const Params& p, int l, char* lds) {
  const bf16* A = (const bf16*)p.hbuf; const bf16* Bt = (const bf16*)(p.WinT + (size_t)l * NG * 4096);
  for (int t = blockIdx.x; t < 1280; t += gridDim.x) gemm_tile<0>(p, l, A, Bt, 40, t);
  for (int rb = blockIdx.x; rb < 256; rb += gridDim.x) lr_tile(p, l, rb, lds);
}
__device__ __forceinline__ void phase_gemm_out(const Params& p, int l) {
  const bf16* A = (const bf16*)p.merged; const bf16* Bt = (const bf16*)(p.WoutT + (size_t)l * 4096 * 4096);
  for (int t = blockIdx.x; t < 512; t += gridDim.x) gemm_tile<1>(p, l, A, Bt, 16, t);
}

__device__ __forceinline__ void seq_of_row(int row0, int& seq_start, int& T) {
  if (row0 < 4096) { seq_start = row0 & ~255; T = 256; } else { seq_start = 4096 + ((row0 - 4096) & ~2047); T = 2048; }
}

#define LDS_BAR() asm volatile("s_waitcnt lgkmcnt(0)\n\ts_barrier" ::: "memory")
__device__ __forceinline__ void lru_m1(const Params& p, int l, int jt, int hb, char* lds) {
  const int tid = otid(), wid = tid >> 6, lane = tid & 63, fr = lane & 15, fq = lane >> 4;
  const int row0 = jt * 64; int seq_start, T; seq_of_row(row0, seq_start, T);
  float* XIN = (float*)lds;
  float* AV = (float*)lds;
  float* XC = (float*)(lds + 34304);
  bfu* XA = (bfu*)(lds + 67328);
  bfu* WB = (bfu*)(lds + 84736);
  float* INP = (float*)(lds + 67328);
  float* SUM = (float*)(lds + 100352);
  const int wr = wid >> 2, wc = wid & 3;
  uint4 raw[3]; bool okv[3];
#pragma unroll
  for (int i = 0; i < 3; ++i) {
    const int id = tid + 512 * i, r = id >> 4, row = row0 - 2 + r;
    okv[i] = id < 67 * 16 && row >= seq_start && row < seq_start + T;
    const int rowc = okv[i] ? row : row0;
    raw[i] = *(const uint4*)(p.u + (size_t)rowc * NU + C_LRUX + hb * 128 + (id & 15) * 8);
  }
  const int cc = tid & 127, chc = hb * 128 + cc;
  const float w0 = p.conv_w[(l * 4 + 0) * 1024 + chc], w1 = p.conv_w[(l * 4 + 1) * 1024 + chc], w2 = p.conv_w[(l * 4 + 2) * 1024 + chc],
              w3 = p.conv_w[(l * 4 + 3) * 1024 + chc], cb = p.conv_b[l * 1024 + chc];
  float4 gba[2][2], gbx[2][2], glm[2][2];
#pragma unroll
  for (int d = 0; d < 2; ++d)
#pragma unroll
    for (int ni = 0; ni < 2; ++ni) {
      const int ch4 = (l * 2 + d) * 1024 + hb * 128 + wc * 32 + ni * 16 + fq * 4;
      gba[d][ni] = *(const float4*)(p.lru_ba + ch4); gbx[d][ni] = *(const float4*)(p.lru_bx + ch4); glm[d][ni] = *(const float4*)(p.sp8 + ch4);
    }
  uint4 wg0, wg1, wg2, wg3;
  const int wsrc = (tid >> 4) * 128 + (tid & 15) * 8, wdst = (tid >> 4) * 136 + (tid & 15) * 8;
  {
    const bfu* src = p.WgT + (size_t)((l * 4 + 0) * 8 + hb) * 16384 + wsrc;
    wg0 = *(const uint4*)(src); wg1 = *(const uint4*)(src + 32 * 128); wg2 = *(const uint4*)(src + 64 * 128); wg3 = *(const uint4*)(src + 96 * 128);
  }
#pragma unroll
  for (int i = 0; i < 3; ++i) {
    const int id = tid + 512 * i;
    if (id < 67 * 16) {
      float xv[8]; unpack8(raw[i], xv);
      float* dstp = XIN + (id >> 4) * 128 + (id & 15) * 8;
      const float z = okv[i] ? 1.f : 0.f;
      *(float4*)dstp = make_float4(xv[0] * z, xv[1] * z, xv[2] * z, xv[3] * z);
      *(float4*)(dstp + 4) = make_float4(xv[4] * z, xv[5] * z, xv[6] * z, xv[7] * z);
    }
  }
  LDS_BAR();
  float xcv[16];
#pragma unroll
  for (int i = 0; i < 16; ++i) {
    const int t = (tid >> 7) + 4 * i;
    xcv[i] = w0 * XIN[t * 128 + cc] + w1 * XIN[(t + 1) * 128 + cc] + w2 * XIN[(t + 2) * 128 + cc] + w3 * XIN[(t + 3) * 128 + cc] + cb;
  }
#pragma unroll
  for (int i = 0; i < 16; ++i) { const int t = (tid >> 7) + 4 * i; XC[t * 129 + cc] = xcv[i]; XA[t * 136 + cc] = f2bf(xcv[i]); }
  f32x4 acc[4][2][2];
#pragma unroll
  for (int m = 0; m < 4; ++m) {
    if (m > 0) LDS_BAR();
    *(uint4*)(WB + wdst) = wg0; *(uint4*)(WB + wdst + 32 * 136) = wg1; *(uint4*)(WB + wdst + 64 * 136) = wg2; *(uint4*)(WB + wdst + 96 * 136) = wg3;
    if (m < 3) {
      const bfu* src = p.WgT + (size_t)((l * 4 + m + 1) * 8 + hb) * 16384 + wsrc;
      wg0 = *(const uint4*)(src); wg1 = *(const uint4*)(src + 32 * 128); wg2 = *(const uint4*)(src + 64 * 128); wg3 = *(const uint4*)(src + 96 * 128);
    }
    LDS_BAR();
#pragma unroll
    for (int mi = 0; mi < 2; ++mi)
#pragma unroll
      for (int ni = 0; ni < 2; ++ni) {
        f32x4 z = {0, 0, 0, 0};
        acc[m][mi][ni] = tile16(z, XA, 136, WB, 136, wr * 32 + mi * 16, wc * 32 + ni * 16, 128, lane);
      }
  }
#pragma unroll
  for (int d = 0; d < 2; ++d) {
    LDS_BAR();
#pragma unroll
    for (int ni = 0; ni < 2; ++ni)
#pragma unroll
      for (int j = 0; j < 4; ++j) {
        const int c = wc * 32 + ni * 16 + fq * 4 + j;
        const float ba = f4get(gba[d][ni], j), bx = f4get(gbx[d][ni], j);
        const float sp8 = f4get(glm[d][ni], j);
#pragma unroll
        for (int mi = 0; mi < 2; ++mi) {
          const int t = wr * 32 + mi * 16 + fr;
          const float r = __builtin_amdgcn_rcpf(1.f + __expf(-(acc[d * 2][mi][ni][j] + ba)));
          const float ig = __builtin_amdgcn_rcpf(1.f + __expf(-(acc[d * 2 + 1][mi][ni][j] + bx)));
          const float log_a = r * sp8, y = 2.f * log_a;
          const float a = __expf(log_a);
          const float om = (y > -0.05f) ? -y * (1.f + y * (0.5f + y * (0.16666667f + y * 0.041666667f))) : 1.f - __expf(y);
          AV[t * 129 + c] = a; INP[t * 129 + c] = __builtin_amdgcn_sqrtf(om) * (ig * XC[t * 129 + c]);
        }
      }
    LDS_BAR();
    {
      const int c = tid & 127, sg = tid >> 7, ch = hb * 128 + c;
      float hl[16], cl[16]; float H = 0.f, CP = 1.f;
#pragma unroll
      for (int s2 = 0; s2 < 16; ++s2) {
        const int q = sg * 16 + s2, t = d == 0 ? q : 63 - q;
        const float a = AV[t * 129 + c];
        H = a * H + INP[t * 129 + c]; CP *= a; hl[s2] = H; cl[s2] = CP;
      }
      SUM[(sg * 128 + c) * 2] = H; SUM[(sg * 128 + c) * 2 + 1] = CP;
      LDS_BAR();
      float Hc = 0.f, Cc = 1.f;
      for (int s3 = 0; s3 < sg; ++s3) { const float sh = SUM[(s3 * 128 + c) * 2], scp = SUM[(s3 * 128 + c) * 2 + 1]; Hc = sh + scp * Hc; Cc *= scp; }
      bfu* hlp = p.scan + (size_t)(d * 2) * 8388608; bfu* cpp_ = p.scan + (size_t)(d * 2 + 1) * 8388608;
#pragma unroll
      for (int s2 = 0; s2 < 16; ++s2) {
        const int q = sg * 16 + s2, t = d == 0 ? q : 63 - q;
        hlp[(size_t)(row0 + t) * 1024 + ch] = f2bf(hl[s2] + cl[s2] * Hc); cpp_[(size_t)(row0 + t) * 1024 + ch] = f2bf(cl[s2] * Cc);
      }
      if (sg == 3) *(float2*)(p.lsum + ((size_t)(d * 128 + jt) * 1024 + ch) * 2) = make_float2(hl[15] + cl[15] * Hc, cl[15] * Cc);
    }
  }
  LDS_BAR();
}

__device__ __forceinline__ void gla_prep(const Params& p, int l, int row0, int h, float* BC, char* scratch) {
  const int tid = otid();
  float* LRS = (float*)scratch;
  float* WUP = (float*)(scratch + 8192);
  float* BUP = (float*)(scratch + 16384);
  for (int idx = tid; idx < 2048; idx += 512) {
    LRS[idx] = bf2f(p.u[(size_t)(row0 + (idx >> 5)) * NU + C_LR + (idx & 31)]);
    int d = idx >> 10, r = (idx >> 6) & 15, dk = idx & 63;
    WUP[idx] = p.gla_wup[((size_t)(l * 2 + d) * 16 + r) * 512 + h * 64 + dk];
  }
  if (tid < 128) BUP[tid] = p.gla_bup[(l * 2 + (tid >> 6)) * 512 + h * 64 + (tid & 63)];
  __syncthreads();
  {
    const int dk = tid & 63, tq = tid >> 6;
#pragma unroll
    for (int d = 0; d < 2; ++d) {
      float w[16];
#pragma unroll
      for (int r = 0; r < 16; ++r) w[r] = WUP[(d * 16 + r) * 64 + dk];
      const float bu = BUP[d * 64 + dk];
#pragma unroll
      for (int i = 0; i < 8; ++i) {
        const int t = tq + 8 * i;
        const float4* lr4 = (const float4*)(LRS + t * 32 + d * 16);
        const float4 l0 = lr4[0], l1 = lr4[1], l2 = lr4[2], l3 = lr4[3];
        float z = bu + l0.x * w[0] + l0.y * w[1] + l0.z * w[2] + l0.w * w[3] + l1.x * w[4] + l1.y * w[5] + l1.z * w[6] + l1.w * w[7]
                + l2.x * w[8] + l2.y * w[9] + l2.z * w[10] + l2.w * w[11] + l3.x * w[12] + l3.y * w[13] + l3.z * w[14] + l3.w * w[15];
        float ls = fminf(z, 0.f) - __logf(1.f + __expf(-fabsf(z)));
        BC[(d * 64 + t) * 64 + dk] = ls * (1.f / 16.f);
      }
    }
  }
  __syncthreads();
  {
    const int pr = tid & 127, sg = tid >> 7, d = pr >> 6, dk = pr & 63;
    float* SEG = LRS;
    float v[16]; float sum = 0.f;
#pragma unroll
    for (int s2 = 0; s2 < 16; ++s2) { const int q = sg * 16 + s2, t = d == 0 ? q : 63 - q; sum += BC[(d * 64 + t) * 64 + dk]; v[s2] = sum; }
    SEG[sg * 128 + pr] = sum;
    __syncthreads();
    float off = 0.f;
    for (int s3 = 0; s3 < sg; ++s3) off += SEG[s3 * 128 + pr];
#pragma unroll
    for (int s2 = 0; s2 < 16; ++s2) { const int q = sg * 16 + s2, t = d == 0 ? q : 63 - q; BC[(d * 64 + t) * 64 + dk] = v[s2] + off; }
  }
  __syncthreads();
}

__device__ __forceinline__ void gla_m1(const Params& p, int l, int g, int h, char* lds) {
  const int tid = otid(), wid = tid >> 6, lane = tid & 63, fr = lane & 15, fq = lane >> 4, row0 = g * 64;
  float* BC = (float*)(lds + 17408);
  bfu* KT = (bfu*)(lds + 50176);
  bfu* VT = (bfu*)(lds + 68608);
  gla_prep(p, l, row0, h, BC, lds);
  {
    const int t = tid >> 3, s8 = tid & 7;
    float kf[8]; unpack8(*(const uint4*)(p.u + (size_t)(row0 + t) * NU + C_GLAK + h * 64 + s8 * 8), kf);
#pragma unroll
    for (int e = 0; e < 8; ++e) {
      int dk = s8 * 8 + e;
      KT[dk * 72 + t] = f2bf(kf[e] * __expf(BC[63 * 64 + dk] - BC[t * 64 + dk]));
      KT[(64 + dk) * 72 + t] = f2bf(kf[e] * __expf(BC[(64 + 0) * 64 + dk] - BC[(64 + t) * 64 + dk]));
    }
    const bfu* vp = p.u + (size_t)(row0 + t) * NU + C_GLAV + h * 128 + s8 * 16;
    float vf[16]; unpack8(*(const uint4*)vp, vf); unpack8(*(const uint4*)(vp + 8), vf + 8);
#pragma unroll
    for (int e = 0; e < 16; ++e) VT[(s8 * 16 + e) * 72 + t] = f2bf(vf[e]);
  }
  if (tid < 128) { int d = tid >> 6, dk = tid & 63; p.dec[((size_t)(g * 8 + h) * 2 + d) * 64 + dk] = __expf(d == 0 ? BC[63 * 64 + dk] : BC[64 * 64 + dk]); }
  __syncthreads();
  for (int d = 0; d < 2; ++d) {
    float* dst = p.kv + ((size_t)(g * 8 + h) * 2 + d) * 8192;
    for (int i = 0; i < 4; ++i) {
      const int m0 = wid * 16, n0 = i * 16;
      f32x4 z = {0, 0, 0, 0};
      f32x4 a = tile16(z, VT, 72, KT + d * 64 * 72, 72, m0, n0, 64, lane);
      *(float4*)(dst + (m0 + fr) * 64 + n0 + fq * 4) = *(float4*)&a;
    }
  }
  __syncthreads();
}

__device__ __forceinline__ void prep_job(const Params& p, int l, int j, int tid) {
  const int wid = tid >> 6, lane = tid & 63, sub = lane >> 4, c = lane & 15;
  bfu* kb_ = opq(p.Kb); bfu* vb_ = opq(p.Vb); const float* qn = opq(p.qnorm); const float* kn = opq(p.knorm);
  const bool lat = j >= 256;
  for (int it0 = wid; it0 < 96; it0 += 24) {
   uint4 rawv[3];
#pragma unroll
   for (int k = 0; k < 3; ++k) {
     const int it = it0 + 8 * k, tok = it / 6, grp = it % 6, row = j * 16 + tok, vec = grp * 4 + sub;
     const int glb = vec >= 12 ? 1 : 0, v12 = vec - glb * 12;
     rawv[k] = *(const uint4*)(p.u + (size_t)row * NU + (glb ? C_GLBQ : C_SWAQ) + v12 * 128 + c * 8);
   }
#pragma unroll
   for (int k = 0; k < 3; ++k) {
    const int it = it0 + 8 * k;
    const int tok = it / 6, grp = it % 6, row = j * 16 + tok, vec = grp * 4 + sub;
    int b, t;
    if (!lat) { b = row >> 8; t = row & 255; } else { int r = row - 4096; b = r >> 11; t = r & 2047; }
    const int glb = vec >= 12 ? 1 : 0, v12 = vec - glb * 12;
    const int kind = v12 < 8 ? 0 : (v12 < 10 ? 1 : 2), hh = kind == 0 ? v12 : (v12 & 1);
    float x[8]; unpack8(rawv[k], x);
    float ss = 0.f;
#pragma unroll
    for (int e = 0; e < 8; ++e) ss += x[e] * x[e];
    ss += __shfl_xor(ss, 1); ss += __shfl_xor(ss, 2); ss += __shfl_xor(ss, 4); ss += __shfl_xor(ss, 8);
    if (glb && kind < 2) {
      const float rs = rsqrtf(ss * (1.f / 128.f) + 1e-6f);
      const float* w = (kind == 0 ? qn : kn) + l * 128 + c * 8;
      float4 w0 = *(const float4*)w, w1 = *(const float4*)(w + 4);
      x[0] *= rs * w0.x; x[1] *= rs * w0.y; x[2] *= rs * w0.z; x[3] *= rs * w0.w;
      x[4] *= rs * w1.x; x[5] *= rs * w1.y; x[6] *= rs * w1.z; x[7] *= rs * w1.w;
    }
    float y[8];
#pragma unroll
    for (int e = 0; e < 8; ++e) y[e] = __shfl_xor(x[e], 4);
    if (lat && kind < 2) {
      const float* rt = p.rope + (size_t)t * 128 + ((c >> 3) * 32 + (c & 3) * 8) * 2;
      const float sgn = (c & 4) ? 1.f : -1.f;
#pragma unroll
      for (int e = 0; e < 8; e += 2) {
        float4 cs = *(const float4*)(rt + e * 2);
        x[e] = x[e] * cs.x + sgn * y[e] * cs.y; x[e + 1] = x[e + 1] * cs.z + sgn * y[e + 1] * cs.w;
      }
    }
    const int type = (lat ? 2 : 0) + glb;
    bfu* dst;
    if (kind == 0) { int T = lat ? 2048 : 256; dst = p.Qb + (size_t)type * 4194304 + ((size_t)(b * 8 + hh) * T + t) * 128; }
    else {
      int S = lat ? 2560 : 256, off = lat ? 512 : 0;
      size_t kvoff = type == 0 ? 0 : (type == 1 ? 1048576 : (type == 2 ? 2097152 : 3407872));
      dst = (kind == 1 ? kb_ : vb_) + kvoff + ((size_t)(b * 2 + hh) * S + off + t) * 128;
    }
    *(uint4*)(dst + c * 8) = pack8(x);
    if (!lat && kind > 0) {
      float* o = p.out + OUT_CACHE + (size_t)(glb * 2 + kind - 1) * 2097152 + ((size_t)((b * 2 + l) * 2 + hh) * 256 + t) * 128 + c * 8;
      *(float4*)o = make_float4(x[0], x[1], x[2], x[3]); *(float4*)(o + 4) = make_float4(x[4], x[5], x[6], x[7]);
    }
   }
  }
}

constexpr int M1_LRU = 1024, M1_GLA = 1024, M1_PREP = 512, M1_CACHE = 32, M1_JOBS = M1_LRU + M1_GLA + M1_PREP + M1_CACHE;
__device__ __forceinline__ void phase_m1(const Params& p, int l, char* lds) {
  for (int job = blockIdx.x; job < M1_JOBS; job += gridDim.x) {
    const int tid = otid(), wid = tid >> 6, lane = tid & 63;
    int j = job;
    if (j < M1_LRU) { lru_m1(p, l, j >> 3, j & 7, lds); continue; }
    j -= M1_LRU;
    if (j < M1_GLA) { gla_m1(p, l, j >> 3, j & 7, lds); continue; }
    j -= M1_GLA;
    if (j < M1_PREP) {
      prep_job(p, l, j, tid);
      continue;
    }
    j -= M1_PREP;
    {
      int arr = j >> 3, bk = (j >> 1) & 3, half = j & 1, b = bk >> 1, kvh = bk & 1;
      const float* s0 = opq(p.cswk); const float* s1 = opq(p.cswv); const float* s2 = opq(p.cglk); const float* s3 = opq(p.cglv);
      const float* src = s0;
      if (arr == 1) src = s1;
      if (arr == 2) src = s2;
      if (arr == 3) src = s3;
      src += (size_t)((b * 2 + l) * 2 + kvh) * 65536 + half * 32768;
      bfu* kb_ = opq(p.Kb); bfu* vb_ = opq(p.Vb);
      bfu* dst = ((arr & 1) ? vb_ : kb_) + (arr < 2 ? 2097152 : 3407872) + (size_t)(b * 2 + kvh) * 2560 * 128 + half * 32768;
      for (int i = tid * 8; i < 32768; i += 4096) {
        float4 a = *(const float4*)(src + i), c = *(const float4*)(src + i + 4);
        uint4 o; o.x = cvtpk(a.x, a.y); o.y = cvtpk(a.z, a.w); o.z = cvtpk(c.x, c.y); o.w = cvtpk(c.z, c.w);
        *(uint4*)(dst + i) = o;
      }
    }
  }
}

__device__ __forceinline__ void lru_m2(const Params& p, int l, int jt, int hb) {
  const int tid = otid(), c = tid & 127, tg = tid >> 7, ch = hb * 128 + c, row0 = jt * 64;
  int seq_start, T; seq_of_row(row0, seq_start, T);
  const bool lat = row0 >= 4096; const int b = lat ? (row0 - 4096) >> 11 : row0 >> 8;
  const bfu* hlf = p.scan; const bfu* cpf = p.scan + 8388608; const bfu* hlb = p.scan + 2 * 8388608; const bfu* cpb = p.scan + 3 * 8388608;
  const float* sumf = p.lsum; const float* sumb = p.lsum + (size_t)128 * 1024 * 2;
  float Hf = lat ? p.state_lru[(size_t)((b * 2 + l) * 2 + 0) * 1024 + ch] : 0.f;
  float Hb = lat ? p.state_lru[(size_t)((b * 2 + l) * 2 + 1) * 1024 + ch] : 0.f;
  for (int r = seq_start; r < row0; r += 512) {
    float hh[8], cc[8];
#pragma unroll
    for (int q = 0; q < 8; ++q) { int rr = r + q * 64; bool ok = rr < row0; const float2 sv = *(const float2*)(sumf + ((size_t)((ok ? rr : row0) >> 6) * 1024 + ch) * 2); hh[q] = ok ? sv.x : 0.f; cc[q] = ok ? sv.y : 1.f; }
#pragma unroll
    for (int q = 0; q < 8; ++q) Hf = hh[q] + cc[q] * Hf;
  }
  for (int r = seq_start + T - 64; r > row0; r -= 512) {
    float hh[8], cc[8];
#pragma unroll
    for (int q = 0; q < 8; ++q) { int rr = r - q * 64; bool ok = rr > row0; const float2 sv = *(const float2*)(sumb + ((size_t)((ok ? rr : row0) >> 6) * 1024 + ch) * 2); hh[q] = ok ? sv.x : 0.f; cc[q] = ok ? sv.y : 1.f; }
#pragma unroll
    for (int q = 0; q < 8; ++q) Hb = hh[q] + cc[q] * Hb;
  }
  bfu vhf[16], vcf[16], vhb[16], vcb[16]; bfu vg[16];
#pragma unroll
  for (int i = 0; i < 16; ++i) {
    const int row = row0 + tg * 16 + i; const size_t o = (size_t)row * 1024 + ch;
    vhf[i] = hlf[o]; vcf[i] = cpf[o]; vhb[i] = hlb[o]; vcb[i] = cpb[o]; vg[i] = p.u[(size_t)row * NU + C_LRUG + ch];
  }
#pragma unroll
  for (int i = 0; i < 16; ++i) {
    const int row = row0 + tg * 16 + i;
    const float of = bf2f(vhf[i]) + bf2f(vcf[i]) * Hf, ob = bf2f(vhb[i]) + bf2f(vcb[i]) * Hb;
    p.merged[(size_t)row * 4096 + ch] = f2bf((of + ob) * silu(bf2f(vg[i])));
    if (!lat) {
      if (row == seq_start + T - 1) p.out[OUT_LRU + (size_t)((b * 2 + l) * 2 + 0) * 1024 + ch] = of;
      if (row == seq_start) p.out[OUT_LRU + (size_t)((b * 2 + l) * 2 + 1) * 1024 + ch] = ob;
    }
  }
}

__device__ __forceinline__ void gla_m2(const Params& p, int l, int g, int h, char* lds) {
  const int tid = otid(), wid = tid >> 6, lane = tid & 63, fr = lane & 15, fq = lane >> 4, row0 = g * 64;
  const bool lat = row0 >= 4096; const int b = lat ? (row0 - 4096) >> 11 : row0 >> 8;
  const int gfirst = lat ? 64 + b * 32 : b * 4, glast = lat ? gfirst + 31 : gfirst + 3;
  float* BC = (float*)lds;
  bfu* SBm = (bfu*)lds;
  char* scratch = lds + 36864;
  bfu* PL = (bfu*)(lds + 36864);
  bfu* QI = (bfu*)(lds + 54272);
  bfu* QA = (bfu*)(lds + 71680);
  bfu* VT = (bfu*)(lds + 108544);
  float* OL = (float*)(lds + 54272);
  gla_prep(p, l, row0, h, BC, scratch);
  {
    const int t = tid >> 3, s8 = tid & 7;
    float qf[8], kf[8];
    unpack8(*(const uint4*)(p.u + (size_t)(row0 + t) * NU + C_GLAQ + h * 64 + s8 * 8), qf);
    unpack8(*(const uint4*)(p.u + (size_t)(row0 + t) * NU + C_GLAK + h * 64 + s8 * 8), kf);
    float qi0[8], qi1[8], qa0[8], ka0[8], qa1[8], ka1[8];
#pragma unroll
    for (int e = 0; e < 8; ++e) {
      const int dk = s8 * 8 + e; const float q = qf[e] * 0.125f, k = kf[e];
      const float bf = BC[t * 64 + dk], bb = BC[(64 + t) * 64 + dk], rf = BC[32 * 64 + dk], rb = BC[(64 + 31) * 64 + dk];
      qi0[e] = q * __expf(bf); qi1[e] = q * __expf(bb);
      qa0[e] = q * __expf(bf - rf); ka0[e] = k * __expf(rf - bf);
      qa1[e] = q * __expf(bb - rb); ka1[e] = k * __expf(rb - bb);
    }
    *(uint4*)(QI + t * 136 + s8 * 8) = pack8(qi0); *(uint4*)(QI + t * 136 + 64 + s8 * 8) = pack8(qi1);
    *(uint4*)(QA + t * 72 + s8 * 8) = pack8(qa0); *(uint4*)(QA + 4608 + t * 72 + s8 * 8) = pack8(ka0);
    *(uint4*)(QA + 9216 + t * 72 + s8 * 8) = pack8(qa1); *(uint4*)(QA + 13824 + t * 72 + s8 * 8) = pack8(ka1);
    const bfu* vp = p.u + (size_t)(row0 + t) * NU + C_GLAV + h * 128 + s8 * 16;
    float vf[16]; unpack8(*(const uint4*)vp, vf); unpack8(*(const uint4*)(vp + 8), vf + 8);
#pragma unroll
    for (int e = 0; e < 16; ++e) VT[(s8 * 16 + e) * 72 + t] = f2bf(vf[e]);
  }
  float4 Sf[4], Sb[4];
#pragma unroll
  for (int i = 0; i < 4; ++i) {
    const int idx4 = tid + 512 * i, dv = idx4 >> 4, dk0 = (idx4 & 15) * 4;
    if (lat) {
      const float* s0 = p.state_gla + ((size_t)((b * 2 + l) * 2 + 0) * 8 + h) * 8192 + dk0 * 128 + dv;
      const float* s1 = p.state_gla + ((size_t)((b * 2 + l) * 2 + 1) * 8 + h) * 8192 + dk0 * 128 + dv;
      Sf[i] = make_float4(s0[0], s0[128], s0[256], s0[384]); Sb[i] = make_float4(s1[0], s1[128], s1[256], s1[384]);
    } else { Sf[i] = make_float4(0.f, 0.f, 0.f, 0.f); Sb[i] = make_float4(0.f, 0.f, 0.f, 0.f); }
  }
#define GLA_STEP4(S, d, g0, dir, lim) do { float4 kk[4][4]; float4 dd[4][4];                                                   \
    _Pragma("unroll") for (int q = 0; q < 4; ++q) { int gq = (g0) + (dir) * q; bool ok = (dir) > 0 ? gq < (lim) : gq > (lim); int gc = ok ? gq : (lim); \
      const float* kvp = p.kv + ((size_t)(gc * 8 + h) * 2 + (d)) * 8192; const float* dp = p.dec + ((size_t)(gc * 8 + h) * 2 + (d)) * 64; \
      _Pragma("unroll") for (int i = 0; i < 4; ++i) { int idx4 = tid + 512 * i;                                                \
        kk[q][i] = ok ? *(const float4*)(kvp + idx4 * 4) : make_float4(0.f, 0.f, 0.f, 0.f);                                    \
        dd[q][i] = ok ? *(const float4*)(dp + (idx4 & 15) * 4) : make_float4(1.f, 1.f, 1.f, 1.f); } }                          \
    _Pragma("unroll") for (int q = 0; q < 4; ++q) _Pragma("unroll") for (int i = 0; i < 4; ++i) {                              \
      S[i].x = dd[q][i].x * S[i].x + kk[q][i].x; S[i].y = dd[q][i].y * S[i].y + kk[q][i].y;                                    \
      S[i].z = dd[q][i].z * S[i].z + kk[q][i].z; S[i].w = dd[q][i].w * S[i].w + kk[q][i].w; } } while (0)
  for (int gg = gfirst; gg < g; gg += 4) GLA_STEP4(Sf, 0, gg, 1, g);
  for (int gg = glast; gg > g; gg -= 4) GLA_STEP4(Sb, 1, gg, -1, g);
#undef GLA_STEP4
  if (!lat && (g == glast || g == gfirst)) {
#pragma unroll
    for (int d = 0; d < 2; ++d) {
      if (d == 0 ? g == glast : g == gfirst) {
        const float* kvp = p.kv + ((size_t)(g * 8 + h) * 2 + d) * 8192; const float* dp = p.dec + ((size_t)(g * 8 + h) * 2 + d) * 64;
        float* o = p.out + OUT_GLA + ((size_t)((b * 2 + l) * 2 + d) * 8 + h) * 8192;
#pragma unroll
        for (int i = 0; i < 4; ++i) {
          const int idx4 = tid + 512 * i, dv = idx4 >> 4, dk0 = (idx4 & 15) * 4;
          const float4 k4 = *(const float4*)(kvp + idx4 * 4), d4 = *(const float4*)(dp + dk0), S4 = d == 0 ? Sf[i] : Sb[i];
          o[(dk0 + 0) * 128 + dv] = d4.x * S4.x + k4.x; o[(dk0 + 1) * 128 + dv] = d4.y * S4.y + k4.y;
          o[(dk0 + 2) * 128 + dv] = d4.z * S4.z + k4.z; o[(dk0 + 3) * 128 + dv] = d4.w * S4.w + k4.w;
        }
      }
    }
  }
  __syncthreads();
#pragma unroll
  for (int i = 0; i < 4; ++i) {
    const int idx4 = tid + 512 * i, dv = idx4 >> 4, dk0 = (idx4 & 15) * 4;
    uint2 o0, o1; o0.x = cvtpk(Sf[i].x, Sf[i].y); o0.y = cvtpk(Sf[i].z, Sf[i].w); o1.x = cvtpk(Sb[i].x, Sb[i].y); o1.y = cvtpk(Sb[i].z, Sb[i].w);
    *(uint2*)(SBm + dv * 136 + dk0) = o0; *(uint2*)(SBm + dv * 136 + 64 + dk0) = o1;
  }
  for (int i = 0; i < 2; ++i) {
    const int tile = wid * 2 + i, m0 = (tile >> 2) * 16, n0 = (tile & 3) * 16;
    f32x4 z = {0, 0, 0, 0};
    f32x4 af = tile16(z, QA, 72, QA + 4608, 72, m0, n0, 64, lane);
    f32x4 ab = tile16(z, QA + 9216, 72, QA + 13824, 72, m0, n0, 64, lane);
    const int ti = m0 + fr; float pv[4];
#pragma unroll
    for (int j = 0; j < 4; ++j) { int tj = n0 + fq * 4 + j; pv[j] = (tj <= ti ? af[j] : 0.f) + (tj >= ti ? ab[j] : 0.f); }
    uint2 o; o.x = cvtpk(pv[0], pv[1]); o.y = cvtpk(pv[2], pv[3]);
    *(uint2*)(PL + ti * 72 + n0 + fq * 4) = o;
  }
  __syncthreads();
  f32x4 oacc[4];
#pragma unroll
  for (int i = 0; i < 4; ++i) {
    const int m0 = (wid >> 1) * 16, n0 = ((wid & 1) * 4 + i) * 16;
    f32x4 z = {0, 0, 0, 0};
    z = tile16(z, QI, 136, SBm, 136, m0, n0, 128, lane);
    oacc[i] = tile16(z, PL, 72, VT, 72, m0, n0, 64, lane);
  }
  __syncthreads();
#pragma unroll
  for (int i = 0; i < 4; ++i) {
    const int m0 = (wid >> 1) * 16, n0 = ((wid & 1) * 4 + i) * 16;
    *(float4*)(OL + (m0 + fr) * 128 + n0 + fq * 4) = *(float4*)&oacc[i];
  }
  __syncthreads();
  {
    const int t = tid >> 3, s8 = tid & 7, row = row0 + t;
    float v[16]; float ss = 0.f;
#pragma unroll
    for (int e = 0; e < 16; ++e) { v[e] = OL[t * 128 + s8 * 16 + e]; ss += v[e] * v[e]; }
    ss += __shfl_xor(ss, 1); ss += __shfl_xor(ss, 2); ss += __shfl_xor(ss, 4);
    const float rs = rsqrtf(ss * (1.f / 128.f) + 1e-6f);
    const bfu* gp = p.u + (size_t)row * NU + C_GLAG + h * 128 + s8 * 16;
    float gf[16]; unpack8(*(const uint4*)gp, gf); unpack8(*(const uint4*)(gp + 8), gf + 8);
    float o[16];
#pragma unroll
    for (int e = 0; e < 16; ++e) o[e] = v[e] * rs * p.gla_norm[l * 128 + s8 * 16 + e] * silu(gf[e]);
    bfu* mp = p.merged + (size_t)row * 4096 + 1024 + h * 128 + s8 * 16;
    *(uint4*)mp = pack8(o); *(uint4*)(mp + 8) = pack8(o + 8);
  }
  __syncthreads();
}

constexpr int QBLK = 32, KVBLK = 64;
constexpr float SCALE = 0.088388347648318440f;
constexpr float THR = 8.f;
constexpr size_t SHM_V = KVBLK * 128 * 2, SHM_K = KVBLK * 128 * 2;
#define KSWZ(row, colB) ((row) * 256 + ((colB) ^ (((row) & 7) << 4)))
#define SBAR() __builtin_amdgcn_sched_barrier(0)
__device__ __forceinline__ int crow(int r, int hi) { return (r & 3) + 8 * (r >> 2) + 4 * hi; }
__device__ __forceinline__ void partialSM(f32x16& p0, f32x16& p1, float& m_reg, float& mn, float& alpha) {
  constexpr float C = SCALE * 1.4426950408889634f;
  float pmax = p0[0]; for (int r = 1; r < 16; ++r) pmax = fmaxf(pmax, p0[r]); for (int r = 0; r < 16; ++r) pmax = fmaxf(pmax, p1[r]);
  { auto rr = __builtin_amdgcn_permlane32_swap(__float_as_uint(pmax), __float_as_uint(pmax), false, false);
    pmax = fmaxf(__uint_as_float(rr[0]), __uint_as_float(rr[1])); }
  if (__builtin_expect(__all(pmax - m_reg <= THR / SCALE), 1)) { mn = m_reg; alpha = 1.f; }
  else { mn = fmaxf(m_reg, pmax); alpha = __builtin_amdgcn_exp2f((m_reg - mn) * C); m_reg = mn; }
  float mnC = -mn * C;
  for (int r = 0; r < 16; ++r) p0[r] = fmaf(p0[r], C, mnC); for (int r = 0; r < 16; ++r) p1[r] = fmaf(p1[r], C, mnC);
  for (int r = 0; r < 16; ++r) p0[r] = __builtin_amdgcn_exp2f(p0[r]);
}
__device__ __forceinline__ void finishSM(f32x16& p0, f32x16& p1, float alpha, float& l_reg, bf16x8& pa0, bf16x8& pa1, bf16x8& pa2, bf16x8& pa3) {
  for (int r = 0; r < 16; ++r) p1[r] = __builtin_amdgcn_exp2f(p1[r]);
  float ps = 0; for (int r = 0; r < 16; ++r) ps += p0[r]; for (int r = 0; r < 16; ++r) ps += p1[r];
  { auto rr = __builtin_amdgcn_permlane32_swap(__float_as_uint(ps), __float_as_uint(ps), false, false);
    ps = __uint_as_float(rr[0]) + __uint_as_float(rr[1]); }
  l_reg = l_reg * alpha + ps;
#define PK4(P, BASE, OUT) do { unsigned a0 = cvtpk(P[BASE + 0], P[BASE + 1]), a1 = cvtpk(P[BASE + 2], P[BASE + 3]);   \
    unsigned b0 = cvtpk(P[BASE + 4], P[BASE + 5]), b1 = cvtpk(P[BASE + 6], P[BASE + 7]);                              \
    auto r0 = __builtin_amdgcn_permlane32_swap(a0, b0, false, false); auto r1 = __builtin_amdgcn_permlane32_swap(a1, b1, false, false); \
    u32x4 w = {r0[0], r1[0], r0[1], r1[1]}; OUT = *reinterpret_cast<bf16x8*>(&w); } while (0)
  PK4(p0, 0, pa0); PK4(p0, 8, pa1); PK4(p1, 0, pa2); PK4(p1, 8, pa3);
#undef PK4
}
__device__ __forceinline__ void qkt(f32x16& p0, f32x16& p1, const bf16* Ks, const bf16x8* qr, int r32, int hi) {
  p0 = f32x16{}; p1 = f32x16{};
  for (int d0 = 0; d0 < 8; ++d0) { int cb = (d0 * 16 + hi * 8) * 2;
    bf16x8 b0 = *reinterpret_cast<const bf16x8*>((const char*)Ks + KSWZ(r32, cb));
    bf16x8 b1 = *reinterpret_cast<const bf16x8*>((const char*)Ks + KSWZ(32 + r32, cb));
    p0 = __builtin_amdgcn_mfma_f32_32x32x16_bf16(b0, qr[d0], p0, 0, 0, 0);
    p1 = __builtin_amdgcn_mfma_f32_32x32x16_bf16(b1, qr[d0], p1, 0, 0, 0); }
}
__device__ __forceinline__ int v_st(int k, int c) { const int kk = (k & ~0xC) | ((k & 4) << 1) | ((k & 8) >> 1); return ((kk >> 3) * 4 + (c >> 5)) * 512 + ((kk & 7) * 32 + (c & 31)) * 2; }
__device__ __forceinline__ int v_rd_base(int lane) { return ((lane & 3) << 3) | (((lane >> 2) & 3) << 6) | (((lane >> 4) & 1) << 5) | (((lane >> 5) & 1) << 8); }
constexpr int v_rd_off(int d0, int ks, int half) { return d0 * 512 + ks * 4096 + half * 2048; }
template <int OFF> __device__ __forceinline__ s16x4 tr_read(int vb) {
  s16x4 r; asm volatile("ds_read_b64_tr_b16 %0, %1 offset:%2" : "=&v"(r) : "v"(vb), "i"(OFF) : "memory"); return r;
}
template <int D0> __device__ __forceinline__ void pv_one(f32x16& od, int vb, bf16x8 pa0, bf16x8 pa1, bf16x8 pa2, bf16x8 pa3) {
  const s16x4 l0 = tr_read<v_rd_off(D0, 0, 0)>(vb), h0 = tr_read<v_rd_off(D0, 0, 1)>(vb), l1 = tr_read<v_rd_off(D0, 1, 0)>(vb), h1 = tr_read<v_rd_off(D0, 1, 1)>(vb);
  const s16x4 l2 = tr_read<v_rd_off(D0, 2, 0)>(vb), h2 = tr_read<v_rd_off(D0, 2, 1)>(vb), l3 = tr_read<v_rd_off(D0, 3, 0)>(vb), h3 = tr_read<v_rd_off(D0, 3, 1)>(vb);
  asm volatile("s_waitcnt lgkmcnt(0)" ::: "memory"); SBAR();
#define PK(L, H) (bf16x8){L[0], L[1], L[2], L[3], H[0], H[1], H[2], H[3]}
  od = __builtin_amdgcn_mfma_f32_32x32x16_bf16(pa0, PK(l0, h0), od, 0, 0, 0);
  od = __builtin_amdgcn_mfma_f32_32x32x16_bf16(pa1, PK(l1, h1), od, 0, 0, 0);
  od = __builtin_amdgcn_mfma_f32_32x32x16_bf16(pa2, PK(l2, h2), od, 0, 0, 0);
  od = __builtin_amdgcn_mfma_f32_32x32x16_bf16(pa3, PK(l3, h3), od, 0, 0, 0);
#undef PK
}
__device__ __forceinline__ void pv_d0(f32x16* o, int vb, bf16x8 pa0, bf16x8 pa1, bf16x8 pa2, bf16x8 pa3) {
  pv_one<0>(o[0], vb, pa0, pa1, pa2, pa3); pv_one<1>(o[1], vb, pa0, pa1, pa2, pa3); pv_one<2>(o[2], vb, pa0, pa1, pa2, pa3); pv_one<3>(o[3], vb, pa0, pa1, pa2, pa3);
}

struct AttnJob {
  const bfu* Q; const bfu* K; const bfu* V;
  int NT, nctx, skip;
  int band, qpos0;
  int has_sink; float sink;
  const bfu* gate; bfu* outp;
};

__device__ __forceinline__ void attn_body(const AttnJob& J, char* lds) {
  int tid = threadIdx.x; asm volatile("" : "+v"(tid));
  const int wid = tid >> 6, lane = tid & 63, r32 = lane & 31, hi = lane >> 5;
  bf16* V_lds = (bf16*)lds; bf16* K_lds = (bf16*)(lds + 2 * SHM_V);
  float* wsm = (float*)(lds + 2 * SHM_V + 2 * SHM_K) + wid * 64; float* li_l = wsm; float* al_l = wsm + 32;
  float m_reg = -1e30f, l_reg = 0; f32x16 o[4] = {}; bf16x8 qr[8];
  const bfu* Qw = J.Q + (long)(wid * QBLK + r32) * 128 + hi * 8;
#pragma unroll
  for (int d0 = 0; d0 < 8; ++d0) qr[d0] = *reinterpret_cast<const bf16x8*>(Qw + d0 * 16);
  const int sr = tid >> 4, sc = (tid & 15) * 8, vst0 = v_st(sr, sc), vst1 = v_st(32 + sr, sc);
  const int vb0 = (int)(uintptr_t)V_lds + v_rd_base(lane);
  const bfu* Kh = J.K; const bfu* Vh = J.V;
  const int NT = J.NT, nctx = J.nctx, skip = J.skip;
  struct { bf16x8 vs0, vs1, ks0, ks1; } sr_[2];
#define KOFF(j) ((j) * KVBLK + ((j) >= nctx ? skip : 0))
#define SLOAD(i, k0) do { sr_[i].vs0 = *(const bf16x8*)(&Vh[(long)((k0) + sr) * 128 + sc]); sr_[i].vs1 = *(const bf16x8*)(&Vh[(long)((k0) + 32 + sr) * 128 + sc]); \
    sr_[i].ks0 = *(const bf16x8*)(&Kh[(long)((k0) + sr) * 128 + sc]); sr_[i].ks1 = *(const bf16x8*)(&Kh[(long)((k0) + 32 + sr) * 128 + sc]); } while (0)
#define SWRITE(b, i) do { *(bf16x8*)((char*)V_lds + (b) * SHM_V + vst0) = sr_[i].vs0;          \
    *(bf16x8*)((char*)V_lds + (b) * SHM_V + vst1) = sr_[i].vs1; int kc = sc * 2;               \
    *(bf16x8*)((char*)K_lds + (b) * SHM_K + KSWZ(sr, kc)) = sr_[i].ks0;                       \
    *(bf16x8*)((char*)K_lds + (b) * SHM_K + KSWZ(32 + sr, kc)) = sr_[i].ks1; } while (0)
#define SWAIT() asm volatile("s_waitcnt vmcnt(4)" ::: "memory")
#define RESC(a) do { if (__any((a) < 1.f)) { if (hi == 0) al_l[r32] = (a); asm volatile("s_waitcnt lgkmcnt(0)" ::: "memory"); \
    for (int d = 0; d < 4; ++d) for (int r = 0; r < 16; ++r) o[d][r] *= al_l[crow(r, hi)]; } } while (0)
#define MASK(P0, P1, j) do { if (J.band && (j) >= nctx) { const int kb = KOFF(j) - nctx * KVBLK, qw = J.qpos0 + wid * QBLK; \
    if (kb + 63 - qw > 128 || qw + 31 - kb > 128) { const int qp = qw + r32; \
      _Pragma("unroll") for (int r = 0; r < 16; ++r) { int d0_ = kb + crow(r, hi) - qp, d1_ = d0_ + 32; \
        if (d0_ > 128 || d0_ < -128) P0[r] = -1e30f; if (d1_ > 128 || d1_ < -128) P1[r] = -1e30f; } } } } while (0)
  f32x16 pA0, pA1, pB0, pB1; float mnA, mnB, alA, alB; bf16x8 pa0, pa1, pa2, pa3;
  constexpr int SE = 0, SO = 1;
  SLOAD(SE, KOFF(0)); asm volatile("s_waitcnt vmcnt(0)" ::: "memory"); SWRITE(0, SE); __syncthreads();
  qkt(pA0, pA1, K_lds, qr, r32, hi); MASK(pA0, pA1, 0); partialSM(pA0, pA1, m_reg, mnA, alA);
  SLOAD(SO, KOFF(1)); if (2 < NT) SLOAD(SE, KOFF(2));
  SWAIT(); SWRITE(1, SO); __syncthreads();
  for (int j = 1; j + 1 < NT; j += 2) {
    SBAR(); qkt(pB0, pB1, (bf16*)((char*)K_lds + SHM_K), qr, r32, hi);
    finishSM(pA0, pA1, alA, l_reg, pa0, pa1, pa2, pa3); SBAR();
    SLOAD(SO, KOFF(j + 2)); SBAR();
    pv_d0(o, vb0, pa0, pa1, pa2, pa3); MASK(pB0, pB1, j); partialSM(pB0, pB1, m_reg, mnB, alB);
    __syncthreads(); SWAIT(); SWRITE(0, SE);
    RESC(alB); __syncthreads();
    SBAR(); qkt(pA0, pA1, K_lds, qr, r32, hi);
    finishSM(pB0, pB1, alB, l_reg, pa0, pa1, pa2, pa3); SBAR();
    if (j + 3 < NT) SLOAD(SE, KOFF(j + 3)); SBAR();
    pv_d0(o, vb0 + (int)SHM_V, pa0, pa1, pa2, pa3); MASK(pA0, pA1, j + 1); partialSM(pA0, pA1, m_reg, mnA, alA);
    __syncthreads(); SWAIT(); SWRITE(1, SO);
    RESC(alA); __syncthreads();
  }
  SBAR(); qkt(pB0, pB1, (bf16*)((char*)K_lds + SHM_K), qr, r32, hi);
  finishSM(pA0, pA1, alA, l_reg, pa0, pa1, pa2, pa3); SBAR();
  pv_d0(o, vb0, pa0, pa1, pa2, pa3); MASK(pB0, pB1, NT - 1); partialSM(pB0, pB1, m_reg, mnB, alB);
  __syncthreads(); RESC(alB);
  finishSM(pB0, pB1, alB, l_reg, pa0, pa1, pa2, pa3); SBAR();
  pv_d0(o, vb0 + (int)SHM_V, pa0, pa1, pa2, pa3);
  if (J.has_sink) l_reg += __builtin_amdgcn_exp2f(J.sink * 1.4426950408889634f - m_reg * (SCALE * 1.4426950408889634f));
  if (hi == 0) li_l[r32] = l_reg; asm volatile("s_waitcnt lgkmcnt(0)" ::: "memory");
  float rli[16];
#pragma unroll
  for (int r = 0; r < 16; ++r) rli[r] = __builtin_amdgcn_rcpf(li_l[crow(r, hi)]);
  int t2 = threadIdx.x; asm volatile("" : "+v"(t2));
  const int wid2 = t2 >> 6, r32b = t2 & 31, hib = (t2 >> 5) & 1;
  bfu graw[16][4];
#pragma unroll
  for (int r = 0; r < 16; ++r) {
    const int orow = wid2 * QBLK + crow(r, hib);
#pragma unroll
    for (int d0 = 0; d0 < 4; ++d0) graw[r][d0] = J.gate[(size_t)orow * NU + d0 * 32 + r32b];
  }
#pragma unroll
  for (int r = 0; r < 16; ++r) {
    const int orow = wid2 * QBLK + crow(r, hib);
#pragma unroll
    for (int d0 = 0; d0 < 4; ++d0) {
      const float g = bf2f(graw[r][d0]);
      J.outp[(size_t)orow * 4096 + d0 * 32 + r32b] = f2bf(o[d0][r] * rli[r] * silu(g));
    }
  }
#undef SLOAD
#undef SWRITE
#undef SWAIT
#undef RESC
#undef MASK
#undef KOFF
  __syncthreads();
}

__device__ __forceinline__ void attn_job(const Params& p, int l, int a, char* lds) {
  AttnJob J;
  const int grp = a >> 7, i = a & 127;
  if (grp < 2) {
    const int type = grp == 0 ? 3 : 2, b = i >> 6, h = (i >> 3) & 7, qb = i & 7, q0 = qb * 256;
    const size_t kvoff = type == 2 ? 2097152 : 3407872;
    J.Q = p.Qb + (size_t)type * 4194304 + ((size_t)(b * 8 + h) * 2048 + q0) * 128;
    J.K = p.Kb + kvoff + (size_t)(b * 2 + (h >> 2)) * 2560 * 128; J.V = p.Vb + kvoff + (size_t)(b * 2 + (h >> 2)) * 2560 * 128;
    const int row0 = 4096 + b * 2048 + q0;
    if (type == 3) { J.NT = 40; J.nctx = 40; J.skip = 0; J.band = 0; J.qpos0 = 0; J.has_sink = 0; J.sink = 0.f;
      J.gate = p.u + (size_t)row0 * NU + C_GLBG + h * 128; J.outp = p.merged + (size_t)row0 * 4096 + 3072 + h * 128; }
    else { const int lo = max(0, q0 - 128), hiK = min(2048, q0 + 384);
      J.NT = 8 + (hiK - lo) / 64; J.nctx = 8; J.skip = lo; J.band = 1; J.qpos0 = q0; J.has_sink = 1; J.sink = p.swa_sink[l * 8 + h];
      J.gate = p.u + (size_t)row0 * NU + C_SWAG + h * 128; J.outp = p.merged + (size_t)row0 * 4096 + 2048 + h * 128; }
  } else {
    const int type = grp == 2 ? 0 : 1, b = i >> 3, h = i & 7;
    const size_t kvoff = type == 0 ? 0 : 1048576;
    J.Q = p.Qb + (size_t)type * 4194304 + (size_t)(b * 8 + h) * 256 * 128;
    J.K = p.Kb + kvoff + (size_t)(b * 2 + (h >> 2)) * 256 * 128; J.V = p.Vb + kvoff + (size_t)(b * 2 + (h >> 2)) * 256 * 128;
    const int row0 = b * 256;
    J.NT = 4; J.nctx = 4; J.skip = 0; J.band = 0; J.qpos0 = 0;
    if (type == 0) { J.has_sink = 1; J.sink = p.swa_sink[l * 8 + h];
      J.gate = p.u + (size_t)row0 * NU + C_SWAG + h * 128; J.outp = p.merged + (size_t)row0 * 4096 + 2048 + h * 128; }
    else { J.has_sink = 0; J.sink = 0.f;
      J.gate = p.u + (size_t)row0 * NU + C_GLBG + h * 128; J.outp = p.merged + (size_t)row0 * 4096 + 3072 + h * 128; }
  }
  attn_body(J, lds);
}

constexpr int M2_ATT = 512, M2_GLA = 1024, M2_LRU = 1024, M2_JOBS = M2_ATT + M2_GLA + M2_LRU;
__device__ __forceinline__ void phase_m2(const Params& p, int l, char* lds) {
  for (int bb = blockIdx.x; bb < 256; bb += gridDim.x) {
    const int natt = bb < 128 ? 1 : 3;
    for (int k = 0; k < natt; ++k) attn_job(p, l, k == 0 ? bb : 256 + (bb - 128) * 2 + (k - 1), lds);
    for (int k = 0; k < 4; ++k) { const int j = bb + 256 * k; gla_m2(p, l, j >> 3, j & 7, lds); }
    for (int k = 0; k < 4; ++k) { const int j = bb + 256 * k; lru_m2(p, l, j >> 3, j & 7); }
  }
}

#define XB_TMO      128
#define XB_XCNT(j)  (256  + 64 * (j))
#define XB_XSUB(j)  (1280 + 64 * (j))
#define XB_XGEN(j)  (2304 + 64 * (j))
#define XB_TOP      3328
#define XB_TOPGEN   3392
#define XCD_BAR_WORDS 3456
#define XB_SPIN_CAP (1u << 18)
#define LAS __attribute__((address_space(3)))
__device__ __forceinline__ unsigned xb_ld(unsigned* p)              { return __hip_atomic_load(p, __ATOMIC_RELAXED, __HIP_MEMORY_SCOPE_AGENT); }
__device__ __forceinline__ unsigned xb_add(unsigned* p, unsigned v) { return __hip_atomic_fetch_add(p, v, __ATOMIC_RELAXED, __HIP_MEMORY_SCOPE_AGENT); }
__device__ __forceinline__ unsigned xb_xcc_id() { return (unsigned)__builtin_amdgcn_s_getreg((3 << 11) | 20) & 0xFu; }
#define XB_SPIN(cond, bar) do { unsigned _sp = 0; while (cond) { __builtin_amdgcn_s_sleep(1); \
    if ((++_sp & 255u) == 0u) { if (xb_ld(&(bar)[XB_TMO])) break; if (_sp > XB_SPIN_CAP) { atomicAdd(&(bar)[XB_TMO], 1u); break; } } } } while (0)
struct XcdBarrier { unsigned* bar; unsigned x; volatile LAS unsigned* st; };
__device__ __forceinline__ XcdBarrier xcd_barrier_post(unsigned* bar, volatile LAS unsigned* st) {
  XcdBarrier b; b.bar = bar; b.x = xb_xcc_id(); b.st = st;
  if (threadIdx.x == 0) (void)xb_add(&bar[XB_XCNT(b.x)], 1u);
  return b;
}
__device__ __forceinline__ void xcd_barrier_complete(unsigned* bar, unsigned x, unsigned& nloc, unsigned& nx) {
  const unsigned G = gridDim.x * gridDim.y * gridDim.z;
  unsigned sum, cnt, mine, sp = 0u;
  for (;;) {
    sum = 0u; cnt = 0u; mine = 0u;
#pragma unroll
    for (unsigned j = 0; j < 16; ++j) { const unsigned c = xb_ld(&bar[XB_XCNT(j)]); sum += c; cnt += (c > 0u) ? 1u : 0u; mine = (j == x) ? c : mine; }
    if (sum == G) break;
    __builtin_amdgcn_s_sleep(1);
    if ((++sp & 255u) == 0u) { if (xb_ld(&bar[XB_TMO])) break; if (sp > XB_SPIN_CAP) { atomicAdd(&bar[XB_TMO], 1u); break; } }
  }
  nloc = mine > 0u ? mine : 1u; nx = cnt > 0u ? cnt : 1u;
}
__device__ __forceinline__ void xcd_barrier(const XcdBarrier& b) {
  asm volatile("s_waitcnt vmcnt(0)" ::: "memory");
  __syncthreads();
  if (threadIdx.x == 0) {
    unsigned* bar = b.bar;
    __builtin_amdgcn_s_waitcnt(0);
    unsigned nloc = b.st[0], nx = b.st[1];
    if (nloc == 0u) { xcd_barrier_complete(bar, b.x, nloc, nx); b.st[0] = nloc; b.st[1] = nx; }
    const unsigned old = xb_add(&bar[XB_XSUB(b.x)], 1u);
    const unsigned gen = old / nloc;
    if (old + 1u == (gen + 1u) * nloc) {
      __builtin_amdgcn_fence(__ATOMIC_RELEASE, "agent");
      asm volatile("s_waitcnt vmcnt(0)" ::: "memory");
      const unsigned og = xb_add(&bar[XB_TOP], 1u);
      const unsigned tg = og / nx;
      if (og + 1u == (tg + 1u) * nx) xb_add(&bar[XB_TOPGEN], 1u);
      else XB_SPIN(xb_ld(&bar[XB_TOPGEN]) == tg, bar);
      __builtin_amdgcn_fence(__ATOMIC_ACQUIRE, "agent");
      xb_add(&bar[XB_XGEN(b.x)], 1u);
      asm volatile("s_waitcnt vmcnt(0)" ::: "memory");
    } else {
      XB_SPIN(xb_ld(&bar[XB_XGEN(b.x)]) == gen, bar);
      __builtin_amdgcn_fence(__ATOMIC_ACQUIRE, "agent");
      asm volatile("s_waitcnt vmcnt(0)" ::: "memory");
    }
  }
  __syncthreads();
}

#if MULTI_LAUNCH
__global__ void __launch_bounds__(512, 2) phase_kernel(Params p, int ph) {
  char* lds = (char*)shm;
  switch (ph) {
    case 0: phase0(p, lds); break;
    case 1: phase_norm(p, 0, lds); break;
    case 2: phase_gemm_in(p, 0, lds); break;
    case 3: phase_m1(p, 0, lds); break;
    case 4: phase_m2(p, 0, lds); break;
    case 5: phase_gemm_out(p, 0); break;
    case 6: phase_norm(p, 1, lds); break;
    case 7: phase_gemm_in(p, 1, lds); break;
    case 8: phase_m1(p, 1, lds); break;
    case 9: phase_m2(p, 1, lds); break;
    case 10: phase_gemm_out(p, 1); break;
    case 11: phase_norm(p, 2, lds); break;
  }
}
#else
__global__ void __launch_bounds__(512, 2) mega_kernel(Params p) {
  cg::grid_group grid = cg::this_grid();
  char* lds = (char*)shm;
  volatile LAS unsigned* st = (volatile LAS unsigned*)((LAS char*)shm + SHM_BYTES);
  if (threadIdx.x == 0) { st[0] = 0u; st[1] = 0u; }
  XcdBarrier xb = xcd_barrier_post(p.bar, st);
  if (p.never) grid.sync();
  phase0(p, lds); xcd_barrier(xb);
  phase_norm(p, 0, lds); xcd_barrier(xb);
  phase_gemm_in(p, 0, lds); xcd_barrier(xb);
  phase_m1(p, 0, lds); xcd_barrier(xb);
  phase_m2(p, 0, lds); xcd_barrier(xb);
  phase_gemm_out(p, 0); xcd_barrier(xb);
  phase_norm(p, 1, lds); xcd_barrier(xb);
  phase_gemm_in(p, 1, lds); xcd_barrier(xb);
  phase_m1(p, 1, lds); xcd_barrier(xb);
  phase_m2(p, 1, lds); xcd_barrier(xb);
  phase_gemm_out(p, 1); xcd_barrier(xb);
  phase_norm(p, 2, lds);
}
#endif

static size_t al256(size_t x) { return (x + 255) / 256 * 256; }

extern "C" void kernel_launch(void* const* d_in, const int* in_sizes, int n_in, void* d_out, int out_size, void* d_ws, size_t ws_size,
                              hipStream_t stream) {
  Params p{};
  const float** pf = (const float**)&p;
  for (int i = 0; i < 29; ++i) pf[i] = (const float*)d_in[i];
  p.out = (float*)d_out;
  char* w = (char*)d_ws; size_t off = 0;
  auto take = [&](size_t bytes) { char* r = w + off; off = al256(off + bytes); return r; };
  p.WinT = (bfu*)take((size_t)2 * NG * 4096 * 2);
  p.WlrT = (bfu*)take((size_t)2 * 32 * 4096 * 2);
  p.WoutT = (bfu*)take((size_t)2 * 4096 * 4096 * 2);
  p.WgT = (bfu*)take((size_t)64 * 16384 * 2);
  p.hbuf = (bfu*)take((size_t)NTOK * 4096 * 2);
  p.u = (bfu*)take((size_t)NTOK * NU * 2);
  p.merged = (bfu*)take((size_t)NTOK * 4096 * 2);
  p.Qb = (bfu*)take((size_t)4 * 4194304 * 2);
  p.Kb = (bfu*)take((size_t)4718592 * 2);
  p.Vb = (bfu*)take((size_t)4718592 * 2);
  p.modv = (float*)take((size_t)6 * 12288 * 4);
  p.rope = (float*)take((size_t)2048 * 128 * 4);
  p.xbuf = (bfu*)take((size_t)NTOK * 4096 * 2);
  p.scan = (bfu*)take((size_t)4 * 8388608 * 2);
  p.lsum = (float*)take((size_t)2 * 128 * 1024 * 2 * 4);
  p.kv = (float*)take((size_t)128 * 8 * 2 * 8192 * 4);
  p.dec = (float*)take((size_t)128 * 8 * 2 * 64 * 4);
  p.sp8 = (float*)take((size_t)4096 * 4);
  p.ctr = (unsigned*)take(256);
  p.bar = (unsigned*)take((size_t)XCD_BAR_WORDS * 4);
  if (off > ws_size || n_in != 29) { fprintf(stderr, "kernel_launch: ws too small (%zu > %zu) or n_in %d\n", off, ws_size, n_in); return; }
#if MULTI_LAUNCH
  static int init = 0;
  if (!init) { hipFuncSetAttribute((const void*)phase_kernel, hipFuncAttributeMaxDynamicSharedMemorySize, SHM_BYTES); init = 1; }
  for (int ph = 0; ph < 12; ++ph) hipLaunchKernelGGL(phase_kernel, dim3(256), dim3(512), SHM_BYTES, stream, p, ph);
#else
  static int grid_blocks = 0;
  if (!grid_blocks) {
    hipFuncSetAttribute((const void*)mega_kernel, hipFuncAttributeMaxDynamicSharedMemorySize, SHM_TOTAL);
    int dev = 0, cus = 0, per_cu = 0;
    hipGetDevice(&dev);
    hipDeviceGetAttribute(&cus, hipDeviceAttributeMultiprocessorCount, dev);
    hipOccupancyMaxActiveBlocksPerMultiprocessor(&per_cu, mega_kernel, 512, SHM_TOTAL);
    if (per_cu > 1) per_cu = 1;
    grid_blocks = cus * per_cu;
    if (grid_blocks <= 0) { fprintf(stderr, "occupancy query failed\n"); grid_blocks = 0; return; }
  }
  void* args[] = {&p};
  (void)hipMemsetAsync(p.bar, 0, (size_t)XCD_BAR_WORDS * 4, stream);
  hipError_t e = hipLaunchCooperativeKernel((void*)mega_kernel, dim3(grid_blocks), dim3(512), args, SHM_TOTAL, stream);
  if (e != hipSuccess) fprintf(stderr, "cooperative launch failed: %s (grid %d)\n", hipGetErrorString(e), grid_blocks);
#endif
}
```

```cpp
#include <hip/hip_runtime.h>
#include <hip/hip_bf16.h>
#include <hip/hip_cooperative_groups.h>
#include <cstdio>
namespace cg = cooperative_groups;

#ifndef MULTI_LAUNCH
#define MULTI_LAUNCH 0
#endif

typedef unsigned short bfu;
using bf16 = __hip_bfloat16;
using bf16x8 = __attribute__((ext_vector_type(8))) short;
using s16x4 = __attribute__((ext_vector_type(4))) short;
using f32x4 = __attribute__((ext_vector_type(4))) float;
using f32x16 = __attribute__((ext_vector_type(16))) float;
using u32x4 = __attribute__((ext_vector_type(4))) unsigned;

constexpr int DM = 4096, NTOK = 8192, NU = 10272, NG = 10240;
constexpr int C_LRUX = 0, C_LRUG = 1024, C_GLAQ = 2048, C_GLAK = 2560, C_GLAV = 3072, C_GLAG = 4096, C_SWAQ = 5120, C_SWAK = 6144,
              C_SWAV = 6400, C_SWAG = 6656, C_GLBQ = 7680, C_GLBK = 8704, C_GLBV = 8960, C_GLBG = 9216, C_LR = 10240;
constexpr size_t OUT_Y = 0, OUT_LRU = 33554432, OUT_GLA = 33619968, OUT_CACHE = 37814272;
constexpr int SHM_BYTES = 131072;
constexpr int SHM_TOTAL = SHM_BYTES + 256;

struct Params {
  const float *x_prompt, *x_sample, *c, *state_lru, *state_gla, *cswk, *cswv, *cglk, *cglv, *c_ctx, *norm_w, *w_mod, *b_mod, *w_in,
      *conv_w, *conv_b, *lru_wa, *lru_ba, *lru_wx, *lru_bx, *lru_lam, *gla_wup, *gla_bup, *gla_norm, *swa_sink, *qnorm, *knorm, *w_out, *final_norm;
  float* out;
  bfu *WinT, *WlrT, *WoutT, *WgT, *hbuf, *u, *merged, *Qb, *Kb, *Vb;
  float *modv, *rope, *lsum, *kv, *dec;
  bfu* scan;
  bfu* xbuf;
  float* sp8;
  unsigned* ctr;
  unsigned* bar;
  long never;
};

extern __shared__ __attribute__((aligned(16))) bf16 shm[];

template <typename T> __device__ __forceinline__ T opq(T x) { asm volatile("" : "+s"(x)); return x; }
__device__ __forceinline__ int otid() { int t = threadIdx.x; asm volatile("" : "+v"(t)); return t; }
__device__ __forceinline__ float bf2f(bfu h) { return __uint_as_float(((unsigned)h) << 16); }
__device__ __forceinline__ unsigned cvtpk(float lo, float hi) {
  unsigned r; asm volatile("v_cvt_pk_bf16_f32 %0, %1, %2" : "=v"(r) : "v"(lo), "v"(hi)); return r;
}
__device__ __forceinline__ bfu f2bf(float f) { return (bfu)(cvtpk(f, 0.f) & 0xffffu); }
__device__ __forceinline__ float f4get(float4 v, int j) { return j == 0 ? v.x : (j == 1 ? v.y : (j == 2 ? v.z : v.w)); }
__device__ __forceinline__ float silu(float v) { return v * __builtin_amdgcn_rcpf(1.f + __expf(-v)); }
__device__ __forceinline__ float sigmoidf(float v) { return 1.f / (1.f + __expf(-v)); }
__device__ __forceinline__ float wave_sum(float v) {
#pragma unroll
  for (int o = 32; o; o >>= 1) v += __shfl_xor(v, o);
  return v;
}
__device__ __forceinline__ void unpack8(uint4 v, float* f) {
  f[0] = __uint_as_float(v.x << 16); f[1] = __uint_as_float(v.x & 0xffff0000u);
  f[2] = __uint_as_float(v.y << 16); f[3] = __uint_as_float(v.y & 0xffff0000u);
  f[4] = __uint_as_float(v.z << 16); f[5] = __uint_as_float(v.z & 0xffff0000u);
  f[6] = __uint_as_float(v.w << 16); f[7] = __uint_as_float(v.w & 0xffff0000u);
}
__device__ __forceinline__ uint4 pack8(const float* f) {
  uint4 r; r.x = cvtpk(f[0], f[1]); r.y = cvtpk(f[2], f[3]); r.z = cvtpk(f[4], f[5]); r.w = cvtpk(f[6], f[7]); return r;
}
__device__ __forceinline__ f32x4 tile16(f32x4 acc, const bfu* A, int lda, const bfu* B, int ldb, int m0, int n0, int K, int lane) {
  const int fr = lane & 15, fq = lane >> 4;
  for (int k0 = 0; k0 < K; k0 += 32) {
    bf16x8 a = *reinterpret_cast<const bf16x8*>(A + (m0 + fr) * lda + k0 + fq * 8);
    bf16x8 b = *reinterpret_cast<const bf16x8*>(B + (n0 + fr) * ldb + k0 + fq * 8);
    acc = __builtin_amdgcn_mfma_f32_16x16x32_bf16(b, a, acc, 0, 0, 0);
  }
  return acc;
}

__device__ __forceinline__ void p0_gemv(const Params& p, int job, char* lds) {
  const int l = job >> 7, j0 = (job & 127) * 96, tid = otid();
  float* sv = (float*)lds;
  const float* cctx = opq(p.c_ctx); const float* clat = opq(p.c);
  for (int i = tid; i < 3 * 4096; i += 512) {
    int r = i >> 12, k = i & 4095;
    float v = (r == 0) ? cctx[k] : clat[(r - 1) * 4096 + k];
    sv[i] = v / (1.f + expf(-v));
  }
  __syncthreads();
  float a00 = 0, a01 = 0, a02 = 0, a03 = 0, a10 = 0, a11 = 0, a12 = 0, a13 = 0, a20 = 0, a21 = 0, a22 = 0, a23 = 0;
  const int cl = tid % 24, rl = tid / 24;
  if (rl < 21) {
    const float* W = p.w_mod + (size_t)l * 4096 * 12288 + j0 + cl * 4;
#pragma unroll 8
    for (int k = rl; k < 4096; k += 21) {
      float4 w = *(const float4*)(W + (size_t)k * 12288);
      float s0 = sv[k], s1 = sv[4096 + k], s2 = sv[8192 + k];
      a00 += s0 * w.x; a01 += s0 * w.y; a02 += s0 * w.z; a03 += s0 * w.w;
      a10 += s1 * w.x; a11 += s1 * w.y; a12 += s1 * w.z; a13 += s1 * w.w;
      a20 += s2 * w.x; a21 += s2 * w.y; a22 += s2 * w.z; a23 += s2 * w.w;
    }
  }
  float* red = (float*)(lds + 49152);
  if (rl < 21) {
    float* r0 = red + (rl * 3) * 96 + cl * 4;
    r0[0] = a00; r0[1] = a01; r0[2] = a02; r0[3] = a03;
    r0[96] = a10; r0[97] = a11; r0[98] = a12; r0[99] = a13;
    r0[192] = a20; r0[193] = a21; r0[194] = a22; r0[195] = a23;
  }
  __syncthreads();
  if (tid < 288) {
    int r = tid / 96, j = tid % 96; float s = 0;
    for (int q = 0; q < 21; ++q) s += red[(q * 3 + r) * 96 + j];
    p.modv[(l * 3 + r) * 12288 + j0 + j] = s + p.b_mod[l * 12288 + j0 + j];
  }
  __syncthreads();
}

struct TUnit { const float* src; size_t ldsrc; int k0; bfu* dst; };
__device__ __forceinline__ TUnit p0_unit(const Params& p, int j) {
  TUnit u;
  const float* win = opq(p.w_in); const float* wout = opq(p.w_out); bfu* WinT = opq(p.WinT); bfu* WlrT = opq(p.WlrT); bfu* WoutT = opq(p.WoutT);
  if (j < 2 * 8 * 321) {
    int l = j / (8 * 321), r = j % (8 * 321), kb = r / 321, nt = r % 321, nsrc0 = nt * 32;
    if (nsrc0 < 4096) u.dst = WinT + (size_t)l * NG * 4096 + (size_t)nsrc0 * 4096;
    else if (nsrc0 < 4128) u.dst = WlrT + (size_t)l * 32 * 4096;
    else u.dst = WinT + (size_t)l * NG * 4096 + (size_t)(nsrc0 - 32) * 4096;
    u.src = win + (size_t)l * 4096 * NU + nsrc0; u.ldsrc = NU; u.k0 = kb * 512;
  } else {
    j -= 2 * 8 * 321;
    int l = j / (8 * 128), r = j % (8 * 128), kb = r / 128, nt = r % 128, nsrc0 = nt * 32;
    u.dst = WoutT + (size_t)l * 4096 * 4096 + (size_t)nsrc0 * 4096;
    u.src = wout + (size_t)l * 4096 * 4096 + nsrc0; u.ldsrc = 4096; u.k0 = kb * 512;
  }
  return u;
}
__device__ __forceinline__ void p0_tload(const TUnit& u, int tid, float4* v) {
  const int c4 = tid & 7, r0 = tid >> 3;
#pragma unroll
  for (int i = 0; i < 8; ++i) v[i] = *(const float4*)(u.src + (size_t)(u.k0 + r0 + 64 * i) * u.ldsrc + c4 * 4);
}
__device__ __forceinline__ void p0_tstore(const TUnit& u, int tid, const float4* v, char* lds) {
  bfu* T = (bfu*)lds;
  const int c4 = tid & 7, r0 = tid >> 3;
#pragma unroll
  for (int i = 0; i < 8; ++i) {
    const int k = r0 + 64 * i, ks = (((k >> 3) ^ c4) << 3) | (k & 7);
    T[(c4 * 4 + 0) * 520 + ks] = f2bf(v[i].x); T[(c4 * 4 + 1) * 520 + ks] = f2bf(v[i].y);
    T[(c4 * 4 + 2) * 520 + ks] = f2bf(v[i].z); T[(c4 * 4 + 3) * 520 + ks] = f2bf(v[i].w);
  }
  __syncthreads();
#pragma unroll
  for (int i = 0; i < 4; ++i) {
    int id = tid + 512 * i, n = id >> 6, kc = id & 63;
    uint4 val = *(const uint4*)(T + n * 520 + ((kc ^ (n >> 2)) << 3));
    *(uint4*)(u.dst + (size_t)n * 4096 + u.k0 + kc * 8) = val;
  }
  __syncthreads();
}
__device__ __forceinline__ void p0_transposes(const Params& p, char* lds) {
  const int tid = otid(); constexpr int NUNIT = 2 * 8 * 321 + 2 * 8 * 128;
  int j = blockIdx.x;
  if (j >= NUNIT) return;
  float4 va[8], vb[8];
  TUnit ua = p0_unit(p, j), ub = ua;
  p0_tload(ua, tid, va);
  for (;;) {
    int jn = j + gridDim.x; bool hb = jn < NUNIT;
    if (hb) { ub = p0_unit(p, jn); p0_tload(ub, tid, vb); }
    p0_tstore(ua, tid, va, lds);
    if (!hb) break;
    j = jn + gridDim.x; bool ha = j < NUNIT;
    if (ha) { ua = p0_unit(p, j); p0_tload(ua, tid, va); }
    p0_tstore(ub, tid, vb, lds);
    if (!ha) break;
  }
}

constexpr int P0_GEMV = 256, P0_TIN = 2 * 8 * 321, P0_TOUT = 2 * 8 * 128, P0_WG = 64, P0_ROPE = 256, P0_SP = 8;
constexpr int P0_JOBS = P0_GEMV + P0_TIN + P0_TOUT + P0_WG + P0_ROPE + P0_SP;

__device__ __forceinline__ void phase0(const Params& p, char* lds) {
  if (blockIdx.x == 0 && threadIdx.x < 16) p.ctr[threadIdx.x] = 0;
  for (int job = blockIdx.x; job < P0_JOBS; job += gridDim.x) {
    int j = job;
    if (j < P0_GEMV) { p0_gemv(p, j, lds); continue; }
    j -= P0_GEMV;
    if (j < P0_TIN + P0_TOUT) continue;
    j -= P0_TIN + P0_TOUT;
    if (j < P0_WG) {
      int l = j >> 5, m = (j >> 3) & 3, hb = j & 7, d = m >> 1;
      const float* wxp = opq(p.lru_wx); const float* wap = opq(p.lru_wa);
      const float* src = ((m & 1) ? wxp : wap) + (size_t)((l * 2 + d) * 8 + hb) * 16384;
      bfu* dst = p.WgT + (size_t)j * 16384;
      for (int idx = otid(); idx < 16384; idx += 512) { int jj = idx >> 7, ii = idx & 127; dst[idx] = f2bf(src[ii * 128 + jj]); }
      continue;
    }
    j -= P0_WG;
    if (j >= P0_ROPE) {
      const int e = (j - P0_ROPE) * 512 + otid();
      const float nl = -p.lru_lam[e];
      p.sp8[e] = -8.f * (fmaxf(nl, 0.f) + log1pf(expf(-fabsf(nl))));
      continue;
    }
    {
      int e = j * 512 + otid(), t = e >> 6, a = (e >> 5) & 1, c = e & 31;
      float pos = (float)(a == 0 ? (t >> 6) : (t & 63));
      float inv = powf(10000.f, -(float)c / 32.f);
      float sn, cs; sincosf(pos * inv, &sn, &cs);
      p.rope[e * 2] = cs; p.rope[e * 2 + 1] = sn;
    }
  }
  p0_transposes(p, lds);
}

__device__ __forceinline__ const float* xrow_ptr(const Params& p, int row) {
  const float* xp = opq(p.x_prompt); const float* xs = opq(p.x_sample);
  return row < 4096 ? xp + (size_t)row * 4096 : xs + (size_t)(row - 4096) * 4096;
}
__device__ __forceinline__ void phase_norm(const Params& p, int l, char* lds) {
  float* WA = (float*)lds;
  float* WB = (float*)(lds + 16384);
  for (int rb = blockIdx.x; rb < 256; rb += gridDim.x) {
    const int tid = otid(), wid = tid >> 6, lane = tid & 63;
    const int row0 = rb * 32, cond = row0 < 4096 ? 0 : (row0 < 6144 ? 1 : 2);
    __syncthreads();
    if (l != 2) {
      const float* mv = p.modv + (l * 3 + cond) * 12288;
      for (int i = tid; i < 1024; i += 512) {
        const float4 w = *(const float4*)(p.norm_w + l * 4096 + i * 4), sh = *(const float4*)(mv + i * 4), sc = *(const float4*)(mv + 4096 + i * 4);
        *(float4*)(WA + i * 4) = make_float4(w.x * (1.f + sc.x), w.y * (1.f + sc.y), w.z * (1.f + sc.z), w.w * (1.f + sc.w));
        *(float4*)(WB + i * 4) = sh;
      }
    }
    __syncthreads();
#pragma unroll 1
    for (int i = 0; i < 4; ++i) {
      const int row = row0 + wid * 4 + i;
      float4 v[16]; float ss = 0;
      if (l == 0) {
        const float* xr = xrow_ptr(p, row);
#pragma unroll
        for (int q = 0; q < 16; ++q) v[q] = ((const float4*)xr)[lane + 64 * q];
      } else {
        const uint4* xr = (const uint4*)(p.xbuf + (size_t)row * 4096);
#pragma unroll
        for (int q2 = 0; q2 < 8; ++q2) {
          float t8[8]; unpack8(xr[lane + 64 * q2], t8);
          v[2 * q2] = make_float4(t8[0], t8[1], t8[2], t8[3]); v[2 * q2 + 1] = make_float4(t8[4], t8[5], t8[6], t8[7]);
        }
      }
#pragma unroll
      for (int q = 0; q < 16; ++q) ss += v[q].x * v[q].x + v[q].y * v[q].y + v[q].z * v[q].z + v[q].w * v[q].w;
      ss = wave_sum(ss);
#define NCOL(q) (l == 0 ? (lane + 64 * (q)) * 4 : (lane + 64 * ((q) >> 1)) * 8 + ((q) & 1) * 4)
      const float rs = rsqrtf(ss * (1.f / 4096.f) + 1e-6f);
      if (l == 2) {
        float4 wv[16];
#pragma unroll
        for (int q = 0; q < 16; ++q) wv[q] = *(const float4*)(p.final_norm + NCOL(q));
#pragma unroll
        for (int q = 0; q < 16; ++q) {
          const int col = NCOL(q); const float4 w = wv[q];
          *(float4*)(p.out + OUT_Y + (size_t)row * 4096 + col) = make_float4(v[q].x * rs * w.x, v[q].y * rs * w.y, v[q].z * rs * w.z, v[q].w * rs * w.w);
        }
      } else {
#pragma unroll
        for (int q = 0; q < 16; ++q) {
          const int col = NCOL(q); const float4 a = *(const float4*)(WA + col), b = *(const float4*)(WB + col);
          uint2 o; o.x = cvtpk(v[q].x * rs * a.x + b.x, v[q].y * rs * a.y + b.y); o.y = cvtpk(v[q].z * rs * a.z + b.z, v[q].w * rs * a.w + b.w);
          *(uint2*)(p.hbuf + (size_t)row * 4096 + col) = o;
        }
      }
#undef NCOL
    }
  }
}

constexpr int BM = 256, BK = 64, HALF = 128, NXCD = 8, WGM = 8, HT = HALF * BK;
__device__ __forceinline__ int lds_byte(int r, int c) {
  int st = (r >> 4) * 2 + (c >> 5), rr = r & 15, cc = c & 31, ob = rr * 64 + cc * 2;
  return st * 1024 + (ob ^ (((ob >> 9) & 1) << 5));
}
__device__ __forceinline__ void stage_rc(int b, int& R, int& C) {
  int st = b / 1024, sb = b % 1024, swz = sb ^ (((sb >> 9) & 1) << 5);
  R = (st >> 1) * 16 + swz / 64; C = (st & 1) * 32 + (swz % 64) / 2;
}

template <int MODE>
__device__ __forceinline__ void gemm_tile(const Params& p, int l, const bf16* __restrict__ A, const bf16* __restrict__ Bt, int nN, int wgid) {
  constexpr int K = 4096;
#define SA(b, h) (shm + ((b) * 2 + (h)) * HT)
#define SB(b, h) (shm + (4 + (b) * 2 + (h)) * HT)
#define STAGE(P, BASE, br, kt) do { long _g = (long)(br) * K + (long)(kt) * BK; \
    for (int _i = 0; _i < 2; ++_i) { int _b = tx * 16 + _i * 8192; int _r, _c; stage_rc(_b, _r, _c); \
      __builtin_amdgcn_global_load_lds((const unsigned*)(BASE + _g + (long)_r * K + _c), \
        (unsigned*)((char*)(P) + _b), 16, 0, 0); } } while (0)
#define LDA(dst, b, h) for (int m = 0; m < 4; ++m) for (int k = 0; k < 2; ++k) \
    dst[m][k] = *reinterpret_cast<const bf16x8*>((char*)SA(b, h) + lds_byte(wr * 64 + m * 16 + fr, k * 32 + fq * 8))
#define LDB(dst, b, h) for (int n = 0; n < 2; ++n) for (int k = 0; k < 2; ++k) \
    dst[n][k] = *reinterpret_cast<const bf16x8*>((char*)SB(b, h) + lds_byte(wc * 32 + n * 16 + fr, k * 32 + fq * 8))
#define MMA(ai, bj, At, Bt_) do { __builtin_amdgcn_s_setprio(1); \
    for (int m = 0; m < 4; ++m) for (int n = 0; n < 2; ++n) for (int k = 0; k < 2; ++k) \
      acc[ai][bj][m][n] = __builtin_amdgcn_mfma_f32_16x16x32_bf16(Bt_[n][k], At[m][k], acc[ai][bj][m][n], 0, 0, 0); \
    __builtin_amdgcn_s_setprio(0); } while (0)
#define WAIT_V(n) asm volatile("s_waitcnt vmcnt(" #n ")" ::: "memory")
#define WAIT_L(n) asm volatile("s_waitcnt lgkmcnt(" #n ")" ::: "memory")
#define BAR __builtin_amdgcn_s_barrier()
#define SCHED __builtin_amdgcn_sched_barrier(0)
  const int nM = 32, nwg = nM * nN;
  {
    int q = nwg / NXCD, r = nwg % NXCD, xcd = wgid % NXCD, off = wgid / NXCD;
    wgid = (xcd < r ? xcd * (q + 1) : r * (q + 1) + (xcd - r) * q) + off;
  }
  int nig = WGM * nN, gid = wgid / nig, fm = gid * WGM, gsz = min(nM - fm, WGM);
  int pm = fm + ((wgid % nig) % gsz), pn = (wgid % nig) / gsz, brow = pm * BM, bcol = pn * BM;
  int tx = threadIdx.x; asm volatile("" : "+v"(tx));
  int wid = __builtin_amdgcn_readfirstlane(tx >> 6), lane = tx & 63, wr = wid >> 2, wc = wid & 3, fr = lane & 15, fq = lane >> 4;
  f32x4 acc[2][2][4][2] = {};
  bf16x8 At[4][2], B0[2][2], B1[2][2];
  const int nt = K / BK;
  STAGE(SB(0, 0), Bt, bcol, 0); STAGE(SA(0, 0), A, brow, 0);
  STAGE(SB(0, 1), Bt, bcol + HALF, 0); STAGE(SA(0, 1), A, brow + HALF, 0);
  if (wr == 1) BAR;
  WAIT_V(4); BAR;
  STAGE(SB(1, 0), Bt, bcol, 1); STAGE(SA(1, 0), A, brow, 1); STAGE(SB(1, 1), Bt, bcol + HALF, 1);
  WAIT_V(6); BAR;
  for (int t = 0; t < nt - 2; t += 2) {
    LDB(B0, 0, 0); SCHED; LDA(At, 0, 0); STAGE(SA(1, 1), A, brow + HALF, t + 1);
    WAIT_L(8); BAR; WAIT_L(0); MMA(0, 0, At, B0); BAR; SCHED;
    LDB(B1, 0, 1); STAGE(SB(0, 0), Bt, bcol, t + 2);
    BAR; WAIT_L(0); MMA(0, 1, At, B1); BAR;
    LDA(At, 0, 1); STAGE(SA(0, 0), A, brow, t + 2);
    BAR; WAIT_L(0); MMA(1, 0, At, B0); BAR; SCHED;
    STAGE(SB(0, 1), Bt, bcol + HALF, t + 2);
    WAIT_V(6); BAR; MMA(1, 1, At, B1); BAR;
    LDB(B0, 1, 0); SCHED; LDA(At, 1, 0); STAGE(SA(0, 1), A, brow + HALF, t + 2);
    WAIT_L(8); BAR; WAIT_L(0); MMA(0, 0, At, B0); BAR; SCHED;
    LDB(B1, 1, 1); STAGE(SB(1, 0), Bt, bcol, t + 3);
    BAR; WAIT_L(0); MMA(0, 1, At, B1); BAR;
    LDA(At, 1, 1); STAGE(SA(1, 0), A, brow, t + 3);
    BAR; WAIT_L(0); MMA(1, 0, At, B0); BAR; SCHED;
    STAGE(SB(1, 1), Bt, bcol + HALF, t + 3);
    WAIT_V(6); BAR; MMA(1, 1, At, B1); BAR;
  }
  { LDB(B0, 0, 0); LDA(At, 0, 0); STAGE(SA(1, 1), A, brow + HALF, nt - 1);
    BAR; WAIT_L(0); MMA(0, 0, At, B0); BAR;
    LDB(B1, 0, 1); BAR; WAIT_L(0); MMA(0, 1, At, B1); BAR;
    LDA(At, 0, 1); WAIT_V(4); BAR; WAIT_L(0); MMA(1, 0, At, B0); MMA(1, 1, At, B1); BAR; }
  { LDB(B0, 1, 0); LDA(At, 1, 0); WAIT_V(2); BAR; WAIT_L(0); MMA(0, 0, At, B0); BAR;
    LDB(B1, 1, 1); WAIT_V(0); BAR; WAIT_L(0); MMA(0, 1, At, B1); BAR;
    LDA(At, 1, 1); BAR; WAIT_L(0); MMA(1, 0, At, B0); MMA(1, 1, At, B1); BAR; }
  if (wr == 0) BAR;
  int tx2 = threadIdx.x; asm volatile("" : "+v"(tx2));
  wid = __builtin_amdgcn_readfirstlane(tx2 >> 6); lane = tx2 & 63; wr = wid >> 2; wc = wid & 3; fr = lane & 15; fq = lane >> 4;
  if (MODE == 0) {
#pragma unroll
    for (int ai = 0; ai < 2; ++ai)
#pragma unroll
      for (int m = 0; m < 4; ++m) {
        const int row = brow + ai * HALF + wr * 64 + m * 16 + fr;
#pragma unroll
        for (int bj = 0; bj < 2; ++bj) {
          const f32x4 a0 = acc[ai][bj][m][0], a1 = acc[ai][bj][m][1];
          uint2 o0, o1; o0.x = cvtpk(a0[0], a0[1]); o0.y = cvtpk(a0[2], a0[3]); o1.x = cvtpk(a1[0], a1[1]); o1.y = cvtpk(a1[2], a1[3]);
          const bool odd = fq & 1;
          const unsigned sx = odd ? o0.x : o1.x, sy = odd ? o0.y : o1.y;
          const unsigned rx = (unsigned)__shfl_xor((int)sx, 16), ry = (unsigned)__shfl_xor((int)sy, 16);
          uint4 o; int col;
          if (!odd) { o = make_uint4(o0.x, o0.y, rx, ry); col = bcol + bj * HALF + wc * 32 + fq * 4; }
          else { o = make_uint4(rx, ry, o1.x, o1.y); col = bcol + bj * HALF + wc * 32 + 16 + (fq - 1) * 4; }
          *(uint4*)(p.u + (size_t)row * NU + col) = o;
        }
      }
  } else {
    const int cond = brow < 4096 ? 0 : (brow < 6144 ? 1 : 2);
    float4 g[2][2];
#pragma unroll
    for (int bj = 0; bj < 2; ++bj)
#pragma unroll
      for (int n = 0; n < 2; ++n) g[bj][n] = *(const float4*)(p.modv + (l * 3 + cond) * 12288 + 8192 + bcol + bj * HALF + wc * 32 + n * 16 + fq * 4);
#pragma unroll
    for (int ai = 0; ai < 2; ++ai) {
      float4 xo[4][2][2];
#pragma unroll
      for (int m = 0; m < 4; ++m) {
        const int row = brow + ai * HALF + wr * 64 + m * 16 + fr;
        if (l == 0) {
          const float* xr = xrow_ptr(p, row);
#pragma unroll
          for (int bj = 0; bj < 2; ++bj)
#pragma unroll
            for (int n = 0; n < 2; ++n) xo[m][bj][n] = *(const float4*)(xr + bcol + bj * HALF + wc * 32 + n * 16 + fq * 4);
        } else {
          const bfu* xr = p.xbuf + (size_t)row * 4096;
#pragma unroll
          for (int bj = 0; bj < 2; ++bj)
#pragma unroll
            for (int n = 0; n < 2; ++n) {
              const uint2 r = *(const uint2*)(xr + bcol + bj * HALF + wc * 32 + n * 16 + fq * 4);
              xo[m][bj][n] = make_float4(__uint_as_float(r.x << 16), __uint_as_float(r.x & 0xffff0000u), __uint_as_float(r.y << 16), __uint_as_float(r.y & 0xffff0000u));
            }
        }
      }
#pragma unroll
      for (int m = 0; m < 4; ++m) {
        const int row = brow + ai * HALF + wr * 64 + m * 16 + fr;
#pragma unroll
        for (int bj = 0; bj < 2; ++bj)
#pragma unroll
          for (int n = 0; n < 2; ++n) {
            const int col = bcol + bj * HALF + wc * 32 + n * 16 + fq * 4;
            const f32x4 a = acc[ai][bj][m][n]; const float4 x4 = xo[m][bj][n], g4 = g[bj][n];
            uint2 o; o.x = cvtpk(x4.x + g4.x * a[0], x4.y + g4.y * a[1]); o.y = cvtpk(x4.z + g4.z * a[2], x4.w + g4.w * a[3]);
            *(uint2*)(p.xbuf + (size_t)row * 4096 + col) = o;
          }
      }
    }
  }
  __syncthreads();
#undef SA
#undef SB
#undef STAGE
#undef LDA
#undef LDB
#undef MMA
}

__device__ __forceinline__ void lr_tile(const Params& p, int l, int rb, char* lds) {
  const int tid = otid(), w = tid >> 6, lane = tid & 63, fr = lane & 15, fq = lane >> 4, row0 = rb * 32;
  const bfu* A = p.hbuf + (size_t)row0 * 4096; const bfu* B = p.WlrT + (size_t)l * 32 * 4096;
  f32x4 acc[2][2] = {};
  for (int k0 = w * 512; k0 < w * 512 + 512; k0 += 128) {
    bf16x8 a[4][2], b[4][2];
#pragma unroll
    for (int s4 = 0; s4 < 4; ++s4)
#pragma unroll
      for (int i = 0; i < 2; ++i) {
        a[s4][i] = *reinterpret_cast<const bf16x8*>(A + (size_t)(i * 16 + fr) * 4096 + k0 + s4 * 32 + fq * 8);
        b[s4][i] = *reinterpret_cast<const bf16x8*>(B + (size_t)(i * 16 + fr) * 4096 + k0 + s4 * 32 + fq * 8);
      }
#pragma unroll
    for (int s4 = 0; s4 < 4; ++s4)
#pragma unroll
      for (int mi = 0; mi < 2; ++mi)
#pragma unroll
        for (int ni = 0; ni < 2; ++ni)
          acc[mi][ni] = __builtin_amdgcn_mfma_f32_16x16x32_bf16(b[s4][ni], a[s4][mi], acc[mi][ni], 0, 0, 0);
  }
  float* red = (float*)lds;
#pragma unroll
  for (int mi = 0; mi < 2; ++mi)
#pragma unroll
    for (int ni = 0; ni < 2; ++ni)
#pragma unroll
      for (int j = 0; j < 4; ++j)
        red[w * 1024 + (mi * 16 + fr) * 32 + ni * 16 + fq * 4 + j] = acc[mi][ni][j];
  __syncthreads();
  for (int e = tid; e < 1024; e += 512) {
    float s = 0;
    for (int q = 0; q < 8; ++q) s += red[q * 1024 + e];
    p.u[(size_t)(row0 + (e >> 5)) * NU + C_LR + (e & 31)] = f2bf(s);
  }
  __syncthreads();
}

__device__ __forceinline__ void phase_gemm_in(const Params& p, int l, char* lds) {
  const bf16* A = (const bf16*)p.hbuf; const bf16* Bt = (const bf16*)(p.WinT + (size_t)l * NG * 4096);
  for (int t = blockIdx.x; t < 1280; t += gridDim.x) gemm_tile<0>(p, l, A, Bt, 40, t);
  for (int rb = blockIdx.x; rb < 256; rb += gridDim.x) lr_tile(p, l, rb, lds);
}
__device__ __forceinline__ void phase_gemm_out(const Params& p, int l) {
  const bf16* A = (const bf16*)p.merged; const bf16* Bt = (const bf16*)(p.WoutT + (size_t)l * 4096 * 4096);
  for (int t = blockIdx.x; t < 512; t += gridDim.x) gemm_tile<1>(p, l, A, Bt, 16, t);
}

__device__ __forceinline__ void seq_of_row(int row0, int& seq_start, int& T) {
  if (row0 < 4096) { seq_start = row0 & ~255; T = 256; } else { seq_start = 4096 + ((row0 - 4096) & ~2047); T = 2048; }
}

#define LDS_BAR() asm volatile("s_waitcnt lgkmcnt(0)\n\ts_barrier" ::: "memory")
__device__ __forceinline__ void lru_m1(const Params& p, int l, int jt, int hb, char* lds) {
  const int tid = otid(), wid = tid >> 6, lane = tid & 63, fr = lane & 15, fq = lane >> 4;
  const int row0 = jt * 64; int seq_start, T; seq_of_row(row0, seq_start, T);
  float* XIN = (float*)lds;
  float* AV = (float*)lds;
  float* XC = (float*)(lds + 34304);
  bfu* XA = (bfu*)(lds + 67328);
  bfu* WB = (bfu*)(lds + 84736);
  float* INP = (float*)(lds + 67328);
  float* SUM = (float*)(lds + 100352);
  const int wr = wid >> 2, wc = wid & 3;
  uint4 raw[3]; bool okv[3];
#pragma unroll
  for (int i = 0; i < 3; ++i) {
    const int id = tid + 512 * i, r = id >> 4, row = row0 - 2 + r;
    okv[i] = id < 67 * 16 && row >= seq_start && row < seq_start + T;
    const int rowc = okv[i] ? row : row0;
    raw[i] = *(const uint4*)(p.u + (size_t)rowc * NU + C_LRUX + hb * 128 + (id & 15) * 8);
  }
  const int cc = tid & 127, chc = hb * 128 + cc;
  const float w0 = p.conv_w[(l * 4 + 0) * 1024 + chc], w1 = p.conv_w[(l * 4 + 1) * 1024 + chc], w2 = p.conv_w[(l * 4 + 2) * 1024 + chc],
              w3 = p.conv_w[(l * 4 + 3) * 1024 + chc], cb = p.conv_b[l * 1024 + chc];
  float4 gba[2][2], gbx[2][2], glm[2][2];
#pragma unroll
  for (int d = 0; d < 2; ++d)
#pragma unroll
    for (int ni = 0; ni < 2; ++ni) {
      const int ch4 = (l * 2 + d) * 1024 + hb * 128 + wc * 32 + ni * 16 + fq * 4;
      gba[d][ni] = *(const float4*)(p.lru_ba + ch4); gbx[d][ni] = *(const float4*)(p.lru_bx + ch4); glm[d][ni] = *(const float4*)(p.sp8 + ch4);
    }
  uint4 wg0, wg1, wg2, wg3;
  const int wsrc = (tid >> 4) * 128 + (tid & 15) * 8, wdst = (tid >> 4) * 136 + (tid & 15) * 8;
  {
    const bfu* src = p.WgT + (size_t)((l * 4 + 0) * 8 + hb) * 16384 + wsrc;
    wg0 = *(const uint4*)(src); wg1 = *(const uint4*)(src + 32 * 128); wg2 = *(const uint4*)(src + 64 * 128); wg3 = *(const uint4*)(src + 96 * 128);
  }
#pragma unroll
  for (int i = 0; i < 3; ++i) {
    const int id = tid + 512 * i;
    if (id < 67 * 16) {
      float xv[8]; unpack8(raw[i], xv);
      float* dstp = XIN + (id >> 4) * 128 + (id & 15) * 8;
      const float z = okv[i] ? 1.f : 0.f;
      *(float4*)dstp = make_float4(xv[0] * z, xv[1] * z, xv[2] * z, xv[3] * z);
      *(float4*)(dstp + 4) = make_float4(xv[4] * z, xv[5] * z, xv[6] * z, xv[7] * z);
    }
  }
  LDS_BAR();
  float xcv[16];
#pragma unroll
  for (int i = 0; i < 16; ++i) {
    const int t = (tid >> 7) + 4 * i;
    xcv[i] = w0 * XIN[t * 128 + cc] + w1 * XIN[(t + 1) * 128 + cc] + w2 * XIN[(t + 2) * 128 + cc] + w3 * XIN[(t + 3) * 128 + cc] + cb;
  }
#pragma unroll
  for (int i = 0; i < 16; ++i) { const int t = (tid >> 7) + 4 * i; XC[t * 129 + cc] = xcv[i]; XA[t * 136 + cc] = f2bf(xcv[i]); }
  f32x4 acc[4][2][2];
#pragma unroll
  for (int m = 0; m < 4; ++m) {
    if (m > 0) LDS_BAR();
    *(uint4*)(WB + wdst) = wg0; *(uint4*)(WB + wdst + 32 * 136) = wg1; *(uint4*)(WB + wdst + 64 * 136) = wg2; *(uint4*)(WB + wdst + 96 * 136) = wg3;
    if (m < 3) {
      const bfu* src = p.WgT + (size_t)((l * 4 + m + 1) * 8 + hb) * 16384 + wsrc;
      wg0 = *(const uint4*)(src); wg1 = *(const uint4*)(src + 32 * 128); wg2 = *(const uint4*)(src + 64 * 128); wg3 = *(const uint4*)(src + 96 * 128);
    }
    LDS_BAR();
#pragma unroll
    for (int mi = 0; mi < 2; ++mi)
#pragma unroll
      for (int ni = 0; ni < 2; ++ni) {
        f32x4 z = {0, 0, 0, 0};
        acc[m][mi][ni] = tile16(z, XA, 136, WB, 136, wr * 32 + mi * 16, wc * 32 + ni * 16, 128, lane);
      }
  }
#pragma unroll
  for (int d = 0; d < 2; ++d) {
    LDS_BAR();
#pragma unroll
    for (int ni = 0; ni < 2; ++ni)
#pragma unroll
      for (int j = 0; j < 4; ++j) {
        const int c = wc * 32 + ni * 16 + fq * 4 + j;
        const float ba = f4get(gba[d][ni], j), bx = f4get(gbx[d][ni], j);
        const float sp8 = f4get(glm[d][ni], j);
#pragma unroll
        for (int mi = 0; mi < 2; ++mi) {
          const int t = wr * 32 + mi * 16 + fr;
          const float r = __builtin_amdgcn_rcpf(1.f + __expf(-(acc[d * 2][mi][ni][j] + ba)));
          const float ig = __builtin_amdgcn_rcpf(1.f + __expf(-(acc[d * 2 + 1][mi][ni][j] + bx)));
          const float log_a = r * sp8, y = 2.f * log_a;
          const float a = __expf(log_a);
          const float om = (y > -0.05f) ? -y * (1.f + y * (0.5f + y * (0.16666667f + y * 0.041666667f))) : 1.f - __expf(y);
          AV[t * 129 + c] = a; INP[t * 129 + c] = __builtin_amdgcn_sqrtf(om) * (ig * XC[t * 129 + c]);
        }
      }
    LDS_BAR();
    {
      const int c = tid & 127, sg = tid >> 7, ch = hb * 128 + c;
      float hl[16], cl[16]; float H = 0.f, CP = 1.f;
#pragma unroll
      for (int s2 = 0; s2 < 16; ++s2) {
        const int q = sg * 16 + s2, t = d == 0 ? q : 63 - q;
        const float a = AV[t * 129 + c];
        H = a * H + INP[t * 129 + c]; CP *= a; hl[s2] = H; cl[s2] = CP;
      }
      SUM[(sg * 128 + c) * 2] = H; SUM[(sg * 128 + c) * 2 + 1] = CP;
      LDS_BAR();
      float Hc = 0.f, Cc = 1.f;
      for (int s3 = 0; s3 < sg; ++s3) { const float sh = SUM[(s3 * 128 + c) * 2], scp = SUM[(s3 * 128 + c) * 2 + 1]; Hc = sh + scp * Hc; Cc *= scp; }
      bfu* hlp = p.scan + (size_t)(d * 2) * 8388608; bfu* cpp_ = p.scan + (size_t)(d * 2 + 1) * 8388608;
#pragma unroll
      for (int s2 = 0; s2 < 16; ++s2) {
        const int q = sg * 16 + s2, t = d == 0 ? q : 63 - q;
        hlp[(size_t)(row0 + t) * 1024 + ch] = f2bf(hl[s2] + cl[s2] * Hc); cpp_[(size_t)(row0 + t) * 1024 + ch] = f2bf(cl[s2] * Cc);
      }
      if (sg == 3) *(float2*)(p.lsum + ((size_t)(d * 128 + jt) * 1024 + ch) * 2) = make_float2(hl[15] + cl[15] * Hc, cl[15] * Cc);
    }
  }
  LDS_BAR();
}

__device__ __forceinline__ void gla_prep(const Params& p, int l, int row0, int h, float* BC, char* scratch) {
  const int tid = otid();
  float* LRS = (float*)scratch;
  float* WUP = (float*)(scratch + 8192);
  float* BUP = (float*)(scratch + 16384);
  for (int idx = tid; idx < 2048; idx += 512) {
    LRS[idx] = bf2f(p.u[(size_t)(row0 + (idx >> 5)) * NU + C_LR + (idx & 31)]);
    int d = idx >> 10, r = (idx >> 6) & 15, dk = idx & 63;
    WUP[idx] = p.gla_wup[((size_t)(l * 2 + d) * 16 + r) * 512 + h * 64 + dk];
  }
  if (tid < 128) BUP[tid] = p.gla_bup[(l * 2 + (tid >> 6)) * 512 + h * 64 + (tid & 63)];
  __syncthreads();
  {
    const int dk = tid & 63, tq = tid >> 6;
#pragma unroll
    for (int d = 0; d < 2; ++d) {
      float w[16];
#pragma unroll
      for (int r = 0; r < 16; ++r) w[r] = WUP[(d * 16 + r) * 64 + dk];
      const float bu = BUP[d * 64 + dk];
#pragma unroll
      for (int i = 0; i < 8; ++i) {
        const int t = tq + 8 * i;
        const float4* lr4 = (const float4*)(LRS + t * 32 + d * 16);
        const float4 l0 = lr4[0], l1 = lr4[1], l2 = lr4[2], l3 = lr4[3];
        float z = bu + l0.x * w[0] + l0.y * w[1] + l0.z * w[2] + l0.w * w[3] + l1.x * w[4] + l1.y * w[5] + l1.z * w[6] + l1.w * w[7]
                + l2.x * w[8] + l2.y * w[9] + l2.z * w[10] + l2.w * w[11] + l3.x * w[12] + l3.y * w[13] + l3.z * w[14] + l3.w * w[15];
        float ls = fminf(z, 0.f) - __logf(1.f + __expf(-fabsf(z)));
        BC[(d * 64 + t) * 64 + dk] = ls * (1.f / 16.f);
      }
    }
  }
  __syncthreads();
  {
    const int pr = tid & 127, sg = tid >> 7, d = pr >> 6, dk = pr & 63;
    float* SEG = LRS;
    float v[16]; float sum = 0.f;
#pragma unroll
    for (int s2 = 0; s2 < 16; ++s2) { const int q = sg * 16 + s2, t = d == 0 ? q : 63 - q; sum += BC[(d * 64 + t) * 64 + dk]; v[s2] = sum; }
    SEG[sg * 128 + pr] = sum;
    __syncthreads();
    float off = 0.f;
    for (int s3 = 0; s3 < sg; ++s3) off += SEG[s3 * 128 + pr];
#pragma unroll
    for (int s2 = 0; s2 < 16; ++s2) { const int q = sg * 16 + s2, t = d == 0 ? q : 63 - q; BC[(d * 64 + t) * 64 + dk] = v[s2] + off; }
  }
  __syncthreads();
}

__device__ __forceinline__ void gla_m1(const Params& p, int l, int g, int h, char* lds) {
  const int tid = otid(), wid = tid >> 6, lane = tid & 63, fr = lane & 15, fq = lane >> 4, row0 = g * 64;
  float* BC = (float*)(lds + 17408);
  bfu* KT = (bfu*)(lds + 50176);
  bfu* VT = (bfu*)(lds + 68608);
  gla_prep(p, l, row0, h, BC, lds);
  {
    const int t = tid >> 3, s8 = tid & 7;
    float kf[8]; unpack8(*(const uint4*)(p.u + (size_t)(row0 + t) * NU + C_GLAK + h * 64 + s8 * 8), kf);
#pragma unroll
    for (int e = 0; e < 8; ++e) {
      int dk = s8 * 8 + e;
      KT[dk * 72 + t] = f2bf(kf[e] * __expf(BC[63 * 64 + dk] - BC[t * 64 + dk]));
      KT[(64 + dk) * 72 + t] = f2bf(kf[e] * __expf(BC[(64 + 0) * 64 + dk] - BC[(64 + t) * 64 + dk]));
    }
    const bfu* vp = p.u + (size_t)(row0 + t) * NU + C_GLAV + h * 128 + s8 * 16;
    float vf[16]; unpack8(*(const uint4*)vp, vf); unpack8(*(const uint4*)(vp + 8), vf + 8);
#pragma unroll
    for (int e = 0; e < 16; ++e) VT[(s8 * 16 + e) * 72 + t] = f2bf(vf[e]);
  }
  if (tid < 128) { int d = tid >> 6, dk = tid & 63; p.dec[((size_t)(g * 8 + h) * 2 + d) * 64 + dk] = __expf(d == 0 ? BC[63 * 64 + dk] : BC[64 * 64 + dk]); }
  __syncthreads();
  for (int d = 0; d < 2; ++d) {
    float* dst = p.kv + ((size_t)(g * 8 + h) * 2 + d) * 8192;
    for (int i = 0; i < 4; ++i) {
      const int m0 = wid * 16, n0 = i * 16;
      f32x4 z = {0, 0, 0, 0};
      f32x4 a = tile16(z, VT, 72, KT + d * 64 * 72, 72, m0, n0, 64, lane);
      *(float4*)(dst + (m0 + fr) * 64 + n0 + fq * 4) = *(float4*)&a;
    }
  }
  __syncthreads();
}

__device__ __forceinline__ void prep_job(const Params& p, int l, int j, int tid) {
  const int wid = tid >> 6, lane = tid & 63, sub = lane >> 4, c = lane & 15;
  bfu* kb_ = opq(p.Kb); bfu* vb_ = opq(p.Vb); const float* qn = opq(p.qnorm); const float* kn = opq(p.knorm);
  const bool lat = j >= 256;
  for (int it0 = wid; it0 < 96; it0 += 24) {
   uint4 rawv[3];
#pragma unroll
   for (int k = 0; k < 3; ++k) {
     const int it = it0 + 8 * k, tok = it / 6, grp = it % 6, row = j * 16 + tok, vec = grp * 4 + sub;
     const int glb = vec >= 12 ? 1 : 0, v12 = vec - glb * 12;
     rawv[k] = *(const uint4*)(p.u + (size_t)row * NU + (glb ? C_GLBQ : C_SWAQ) + v12 * 128 + c * 8);
   }
#pragma unroll
   for (int k = 0; k < 3; ++k) {
    const int it = it0 + 8 * k;
    const int tok = it / 6, grp = it % 6, row = j * 16 + tok, vec = grp * 4 + sub;
    int b, t;
    if (!lat) { b = row >> 8; t = row & 255; } else { int r = row - 4096; b = r >> 11; t = r & 2047; }
    const int glb = vec >= 12 ? 1 : 0, v12 = vec - glb * 12;
    const int kind = v12 < 8 ? 0 : (v12 < 10 ? 1 : 2), hh = kind == 0 ? v12 : (v12 & 1);
    float x[8]; unpack8(rawv[k], x);
    float ss = 0.f;
#pragma unroll
    for (int e = 0; e < 8; ++e) ss += x[e] * x[e];
    ss += __shfl_xor(ss, 1); ss += __shfl_xor(ss, 2); ss += __shfl_xor(ss, 4); ss += __shfl_xor(ss, 8);
    if (glb && kind < 2) {
      const float rs = rsqrtf(ss * (1.f / 128.f) + 1e-6f);
      const float* w = (kind == 0 ? qn : kn) + l * 128 + c * 8;
      float4 w0 = *(const float4*)w, w1 = *(const float4*)(w + 4);
      x[0] *= rs * w0.x; x[1] *= rs * w0.y; x[2] *= rs * w0.z; x[3] *= rs * w0.w;
      x[4] *= rs * w1.x; x[5] *= rs * w1.y; x[6] *= rs * w1.z; x[7] *= rs * w1.w;
    }
    float y[8];
#pragma unroll
    for (int e = 0; e < 8; ++e) y[e] = __shfl_xor(x[e], 4);
    if (lat && kind < 2) {
      const float* rt = p.rope + (size_t)t * 128 + ((c >> 3) * 32 + (c & 3) * 8) * 2;
      const float sgn = (c & 4) ? 1.f : -1.f;
#pragma unroll
      for (int e = 0; e < 8; e += 2) {
        float4 cs = *(const float4*)(rt + e * 2);
        x[e] = x[e] * cs.x + sgn * y[e] * cs.y; x[e + 1] = x[e + 1] * cs.z + sgn * y[e + 1] * cs.w;
      }
    }
    const int type = (lat ? 2 : 0) + glb;
    bfu* dst;
    if (kind == 0) { int T = lat ? 2048 : 256; dst = p.Qb + (size_t)type * 4194304 + ((size_t)(b * 8 + hh) * T + t) * 128; }
    else {
      int S = lat ? 2560 : 256, off = lat ? 512 : 0;
      size_t kvoff = type == 0 ? 0 : (type == 1 ? 1048576 : (type == 2 ? 2097152 : 3407872));
      dst = (kind == 1 ? kb_ : vb_) + kvoff + ((size_t)(b * 2 + hh) * S + off + t) * 128;
    }
    *(uint4*)(dst + c * 8) = pack8(x);
    if (!lat && kind > 0) {
      float* o = p.out + OUT_CACHE + (size_t)(glb * 2 + kind - 1) * 2097152 + ((size_t)((b * 2 + l) * 2 + hh) * 256 + t) * 128 + c * 8;
      *(float4*)o = make_float4(x[0], x[1], x[2], x[3]); *(float4*)(o + 4) = make_float4(x[4], x[5], x[6], x[7]);
    }
   }
  }
}

constexpr int M1_LRU = 1024, M1_GLA = 1024, M1_PREP = 512, M1_CACHE = 32, M1_JOBS = M1_LRU + M1_GLA + M1_PREP + M1_CACHE;
__device__ __forceinline__ void phase_m1(const Params& p, int l, char* lds) {
  for (int job = blockIdx.x; job < M1_JOBS; job += gridDim.x) {
    const int tid = otid(), wid = tid >> 6, lane = tid & 63;
    int j = job;
    if (j < M1_LRU) { lru_m1(p, l, j >> 3, j & 7, lds); continue; }
    j -= M1_LRU;
    if (j < M1_GLA) { gla_m1(p, l, j >> 3, j & 7, lds); continue; }
    j -= M1_GLA;
    if (j < M1_PREP) {
      prep_job(p, l, j, tid);
      continue;
    }
    j -= M1_PREP;
    {
      int arr = j >> 3, bk = (j >> 1) & 3, half = j & 1, b = bk >> 1, kvh = bk & 1;
      const float* s0 = opq(p.cswk); const float* s1 = opq(p.cswv); const float* s2 = opq(p.cglk); const float* s3 = opq(p.cglv);
      const float* src = s0;
      if (arr == 1) src = s1;
      if (arr == 2) src = s2;
      if (arr == 3) src = s3;
      src += (size_t)((b * 2 + l) * 2 + kvh) * 65536 + half * 32768;
      bfu* kb_ = opq(p.Kb); bfu* vb_ = opq(p.Vb);
      bfu* dst = ((arr & 1) ? vb_ : kb_) + (arr < 2 ? 2097152 : 3407872) + (size_t)(b * 2 + kvh) * 2560 * 128 + half * 32768;
      for (int i = tid * 8; i < 32768; i += 4096) {
        float4 a = *(const float4*)(src + i), c = *(const float4*)(src + i + 4);
        uint4 o; o.x = cvtpk(a.x, a.y); o.y = cvtpk(a.z, a.w); o.z = cvtpk(c.x, c.y); o.w = cvtpk(c.z, c.w);
        *(uint4*)(dst + i) = o;
      }
    }
  }
}

__device__ __forceinline__ void lru_m2(const Params& p, int l, int jt, int hb) {
  const int tid = otid(), c = tid & 127, tg = tid >> 7, ch = hb * 128 + c, row0 = jt * 64;
  int seq_start, T; seq_of_row(row0, seq_start, T);
  const bool lat = row0 >= 4096; const int b = lat ? (row0 - 4096) >> 11 : row0 >> 8;
  const bfu* hlf = p.scan; const bfu* cpf = p.scan + 8388608; const bfu* hlb = p.scan + 2 * 8388608; const bfu* cpb = p.scan + 3 * 8388608;
  const float* sumf = p.lsum; const float* sumb = p.lsum + (size_t)128 * 1024 * 2;
  float Hf = lat ? p.state_lru[(size_t)((b * 2 + l) * 2 + 0) * 1024 + ch] : 0.f;
  float Hb = lat ? p.state_lru[(size_t)((b * 2 + l) * 2 + 1) * 1024 + ch] : 0.f;
  for (int r = seq_start; r < row0; r += 512) {
    float hh[8], cc[8];
#pragma unroll
    for (int q = 0; q < 8; ++q) { int rr = r + q * 64; bool ok = rr < row0; const float2 sv = *(const float2*)(sumf + ((size_t)((ok ? rr : row0) >> 6) * 1024 + ch) * 2); hh[q] = ok ? sv.x : 0.f; cc[q] = ok ? sv.y : 1.f; }
#pragma unroll
    for (int q = 0; q < 8; ++q) Hf = hh[q] + cc[q] * Hf;
  }
  for (int r = seq_start + T - 64; r > row0; r -= 512) {
    float hh[8], cc[8];
#pragma unroll
    for (int q = 0; q < 8; ++q) { int rr = r - q * 64; bool ok = rr > row0; const float2 sv = *(const float2*)(sumb + ((size_t)((ok ? rr : row0) >> 6) * 1024 + ch) * 2); hh[q] = ok ? sv.x : 0.f; cc[q] = ok ? sv.y : 1.f; }
#pragma unroll
    for (int q = 0; q < 8; ++q) Hb = hh[q] + cc[q] * Hb;
  }
  bfu vhf[16], vcf[16], vhb[16], vcb[16]; bfu vg[16];
#pragma unroll
  for (int i = 0; i < 16; ++i) {
    const int row = row0 + tg * 16 + i; const size_t o = (size_t)row * 1024 + ch;
    vhf[i] = hlf[o]; vcf[i] = cpf[o]; vhb[i] = hlb[o]; vcb[i] = cpb[o]; vg[i] = p.u[(size_t)row * NU + C_LRUG + ch];
  }
#pragma unroll
  for (int i = 0; i < 16; ++i) {
    const int row = row0 + tg * 16 + i;
    const float of = bf2f(vhf[i]) + bf2f(vcf[i]) * Hf, ob = bf2f(vhb[i]) + bf2f(vcb[i]) * Hb;
    p.merged[(size_t)row * 4096 + ch] = f2bf((of + ob) * silu(bf2f(vg[i])));
    if (!lat) {
      if (row == seq_start + T - 1) p.out[OUT_LRU + (size_t)((b * 2 + l) * 2 + 0) * 1024 + ch] = of;
      if (row == seq_start) p.out[OUT_LRU + (size_t)((b * 2 + l) * 2 + 1) * 1024 + ch] = ob;
    }
  }
}

__device__ __forceinline__ void gla_m2(const Params& p, int l, int g, int h, char* lds) {
  const int tid = otid(), wid = tid >> 6, lane = tid & 63, fr = lane & 15, fq = lane >> 4, row0 = g * 64;
  const bool lat = row0 >= 4096; const int b = lat ? (row0 - 4096) >> 11 : row0 >> 8;
  const int gfirst = lat ? 64 + b * 32 : b * 4, glast = lat ? gfirst + 31 : gfirst + 3;
  float* BC = (float*)lds;
  bfu* SBm = (bfu*)lds;
  char* scratch = lds + 36864;
  bfu* PL = (bfu*)(lds + 36864);
  bfu* QI = (bfu*)(lds + 54272);
  bfu* QA = (bfu*)(lds + 71680);
  bfu* VT = (bfu*)(lds + 108544);
  float* OL = (float*)(lds + 54272);
  gla_prep(p, l, row0, h, BC, scratch);
  {
    const int t = tid >> 3, s8 = tid & 7;
    float qf[8], kf[8];
    unpack8(*(const uint4*)(p.u + (size_t)(row0 + t) * NU + C_GLAQ + h * 64 + s8 * 8), qf);
    unpack8(*(const uint4*)(p.u + (size_t)(row0 + t) * NU + C_GLAK + h * 64 + s8 * 8), kf);
    float qi0[8], qi1[8], qa0[8], ka0[8], qa1[8], ka1[8];
#pragma unroll
    for (int e = 0; e < 8; ++e) {
      const int dk = s8 * 8 + e; const float q = qf[e] * 0.125f, k = kf[e];
      const float bf = BC[t * 64 + dk], bb = BC[(64 + t) * 64 + dk], rf = BC[32 * 64 + dk], rb = BC[(64 + 31) * 64 + dk];
      qi0[e] = q * __expf(bf); qi1[e] = q * __expf(bb);
      qa0[e] = q * __expf(bf - rf); ka0[e] = k * __expf(rf - bf);
      qa1[e] = q * __expf(bb - rb); ka1[e] = k * __expf(rb - bb);
    }
    *(uint4*)(QI + t * 136 + s8 * 8) = pack8(qi0); *(uint4*)(QI + t * 136 + 64 + s8 * 8) = pack8(qi1);
    *(uint4*)(QA + t * 72 + s8 * 8) = pack8(qa0); *(uint4*)(QA + 4608 + t * 72 + s8 * 8) = pack8(ka0);
    *(uint4*)(QA + 9216 + t * 72 + s8 * 8) = pack8(qa1); *(uint4*)(QA + 13824 + t * 72 + s8 * 8) = pack8(ka1);
    const bfu* vp = p.u + (size_t)(row0 + t) * NU + C_GLAV + h * 128 + s8 * 16;
    float vf[16]; unpack8(*(const uint4*)vp, vf); unpack8(*(const uint4*)(vp + 8), vf + 8);
#pragma unroll
    for (int e = 0; e < 16; ++e) VT[(s8 * 16 + e) * 72 + t] = f2bf(vf[e]);
  }
  float4 Sf[4], Sb[4];
#pragma unroll
  for (int i = 0; i < 4; ++i) {
    const int idx4 = tid + 512 * i, dv = idx4 >> 4, dk0 = (idx4 & 15) * 4;
    if (lat) {
      const float* s0 = p.state_gla + ((size_t)((b * 2 + l) * 2 + 0) * 8 + h) * 8192 + dk0 * 128 + dv;
      const float* s1 = p.state_gla + ((size_t)((b * 2 + l) * 2 + 1) * 8 + h) * 8192 + dk0 * 128 + dv;
      Sf[i] = make_float4(s0[0], s0[128], s0[256], s0[384]); Sb[i] = make_float4(s1[0], s1[128], s1[256], s1[384]);
    } else { Sf[i] = make_float4(0.f, 0.f, 0.f, 0.f); Sb[i] = make_float4(0.f, 0.f, 0.f, 0.f); }
  }
#define GLA_STEP4(S, d, g0, dir, lim) do { float4 kk[4][4]; float4 dd[4][4];                                                   \
    _Pragma("unroll") for (int q = 0; q < 4; ++q) { int gq = (g0) + (dir) * q; bool ok = (dir) > 0 ? gq < (lim) : gq > (lim); int gc = ok ? gq : (lim); \
      const float* kvp = p.kv + ((size_t)(gc * 8 + h) * 2 + (d)) * 8192; const float* dp = p.dec + ((size_t)(gc * 8 + h) * 2 + (d)) * 64; \
      _Pragma("unroll") for (int i = 0; i < 4; ++i) { int idx4 = tid + 512 * i;                                                \
        kk[q][i] = ok ? *(const float4*)(kvp + idx4 * 4) : make_float4(0.f, 0.f, 0.f, 0.f);                                    \
        dd[q][i] = ok ? *(const float4*)(dp + (idx4 & 15) * 4) : make_float4(1.f, 1.f, 1.f, 1.f); } }                          \
    _Pragma("unroll") for (int q = 0; q < 4; ++q) _Pragma("unroll") for (int i = 0; i < 4; ++i) {                              \
      S[i].x = dd[q][i].x * S[i].x + kk[q][i].x; S[i].y = dd[q][i].y * S[i].y + kk[q][i].y;                                    \
      S[i].z = dd[q][i].z * S[i].z + kk[q][i].z; S[i].w = dd[q][i].w * S[i].w + kk[q][i].w; } } while (0)
  for (int gg = gfirst; gg < g; gg += 4) GLA_STEP4(Sf, 0, gg, 1, g);
  for (int gg = glast; gg > g; gg -= 4) GLA_STEP4(Sb, 1, gg, -1, g);
#undef GLA_STEP4
  if (!lat && (g == glast || g == gfirst)) {
#pragma unroll
    for (int d = 0; d < 2; ++d) {
      if (d == 0 ? g == glast : g == gfirst) {
        const float* kvp = p.kv + ((size_t)(g * 8 + h) * 2 + d) * 8192; const float* dp = p.dec + ((size_t)(g * 8 + h) * 2 + d) * 64;
        float* o = p.out + OUT_GLA + ((size_t)((b * 2 + l) * 2 + d) * 8 + h) * 8192;
#pragma unroll
        for (int i = 0; i < 4; ++i) {
          const int idx4 = tid + 512 * i, dv = idx4 >> 4, dk0 = (idx4 & 15) * 4;
          const float4 k4 = *(const float4*)(kvp + idx4 * 4), d4 = *(const float4*)(dp + dk0), S4 = d == 0 ? Sf[i] : Sb[i];
          o[(dk0 + 0) * 128 + dv] = d4.x * S4.x + k4.x; o[(dk0 + 1) * 128 + dv] = d4.y * S4.y + k4.y;
          o[(dk0 + 2) * 128 + dv] = d4.z * S4.z + k4.z; o[(dk0 + 3) * 128 + dv] = d4.w * S4.w + k4.w;
        }
      }
    }
  }
  __syncthreads();
#pragma unroll
  for (int i = 0; i < 4; ++i) {
    const int idx4 = tid + 512 * i, dv = idx4 >> 4, dk0 = (idx4 & 15) * 4;
    uint2 o0, o1; o0.x = cvtpk(Sf[i].x, Sf[i].y); o0.y = cvtpk(Sf[i].z, Sf[i].w); o1.x = cvtpk(Sb[i].x, Sb[i].y); o1.y = cvtpk(Sb[i].z, Sb[i].w);
    *(uint2*)(SBm + dv * 136 + dk0) = o0; *(uint2*)(SBm + dv * 136 + 64 + dk0) = o1;
  }
  for (int i = 0; i < 2; ++i) {
    const int tile = wid * 2 + i, m0 = (tile >> 2) * 16, n0 = (tile & 3) * 16;
    f32x4 z = {0, 0, 0, 0};
    f32x4 af = tile16(z, QA, 72, QA + 4608, 72, m0, n0, 64, lane);
    f32x4 ab = tile16(z, QA + 9216, 72, QA + 13824, 72, m0, n0, 64, lane);
    const int ti = m0 + fr; float pv[4];
#pragma unroll
    for (int j = 0; j < 4; ++j) { int tj = n0 + fq * 4 + j; pv[j] = (tj <= ti ? af[j] : 0.f) + (tj >= ti ? ab[j] : 0.f); }
    uint2 o; o.x = cvtpk(pv[0], pv[1]); o.y = cvtpk(pv[2], pv[3]);
    *(uint2*)(PL + ti * 72 + n0 + fq * 4) = o;
  }
  __syncthreads();
  f32x4 oacc[4];
#pragma unroll
  for (int i = 0; i < 4; ++i) {
    const int m0 = (wid >> 1) * 16, n0 = ((wid & 1) * 4 + i) * 16;
    f32x4 z = {0, 0, 0, 0};
    z = tile16(z, QI, 136, SBm, 136, m0, n0, 128, lane);
    oacc[i] = tile16(z, PL, 72, VT, 72, m0, n0, 64, lane);
  }
  __syncthreads();
#pragma unroll
  for (int i = 0; i < 4; ++i) {
    const int m0 = (wid >> 1) * 16, n0 = ((wid & 1) * 4 + i) * 16;
    *(float4*)(OL + (m0 + fr) * 128 + n0 + fq * 4) = *(float4*)&oacc[i];
  }
  __syncthreads();
  {
    const int t = tid >> 3, s8 = tid & 7, row = row0 + t;
    float v[16]; float ss = 0.f;
#pragma unroll
    for (int e = 0; e < 16; ++e) { v[e] = OL[t * 128 + s8 * 16 + e]; ss += v[e] * v[e]; }
    ss += __shfl_xor(ss, 1); ss += __shfl_xor(ss, 2); ss += __shfl_xor(ss, 4);
    const float rs = rsqrtf(ss * (1.f / 128.f) + 1e-6f);
    const bfu* gp = p.u + (size_t)row * NU + C_GLAG + h * 128 + s8 * 16;
    float gf[16]; unpack8(*(const uint4*)gp, gf); unpack8(*(const uint4*)(gp + 8), gf + 8);
    float o[16];
#pragma unroll
    for (int e = 0; e < 16; ++e) o[e] = v[e] * rs * p.gla_norm[l * 128 + s8 * 16 + e] * silu(gf[e]);
    bfu* mp = p.merged + (size_t)row * 4096 + 1024 + h * 128 + s8 * 16;
    *(uint4*)mp = pack8(o); *(uint4*)(mp + 8) = pack8(o + 8);
  }
  __syncthreads();
}

constexpr int QBLK = 32, KVBLK = 64;
constexpr float SCALE = 0.088388347648318440f;
constexpr float THR = 8.f;
constexpr size_t SHM_V = KVBLK * 128 * 2, SHM_K = KVBLK * 128 * 2;
#define KSWZ(row, colB) ((row) * 256 + ((colB) ^ (((row) & 7) << 4)))
#define SBAR() __builtin_amdgcn_sched_barrier(0)
__device__ __forceinline__ int crow(int r, int hi) { return (r & 3) + 8 * (r >> 2) + 4 * hi; }
__device__ __forceinline__ void partialSM(f32x16& p0, f32x16& p1, float& m_reg, float& mn, float& alpha) {
  constexpr float C = SCALE * 1.4426950408889634f;
  float pmax = p0[0]; for (int r = 1; r < 16; ++r) pmax = fmaxf(pmax, p0[r]); for (int r = 0; r < 16; ++r) pmax = fmaxf(pmax, p1[r]);
  { auto rr = __builtin_amdgcn_permlane32_swap(__float_as_uint(pmax), __float_as_uint(pmax), false, false);
    pmax = fmaxf(__uint_as_float(rr[0]), __uint_as_float(rr[1])); }
  if (__builtin_expect(__all(pmax - m_reg <= THR / SCALE), 1)) { mn = m_reg; alpha = 1.f; }
  else { mn = fmaxf(m_reg, pmax); alpha = __builtin_amdgcn_exp2f((m_reg - mn) * C); m_reg = mn; }
  float mnC = -mn * C;
  for (int r = 0; r < 16; ++r) p0[r] = fmaf(p0[r], C, mnC); for (int r = 0; r < 16; ++r) p1[r] = fmaf(p1[r], C, mnC);
  for (int r = 0; r < 16; ++r) p0[r] = __builtin_amdgcn_exp2f(p0[r]);
}
__device__ __forceinline__ void finishSM(f32x16& p0, f32x16& p1, float alpha, float& l_reg, bf16x8& pa0, bf16x8& pa1, bf16x8& pa2, bf16x8& pa3) {
  for (int r = 0; r < 16; ++r) p1[r] = __builtin_amdgcn_exp2f(p1[r]);
  float ps = 0; for (int r = 0; r < 16; ++r) ps += p0[r]; for (int r = 0; r < 16; ++r) ps += p1[r];
  { auto rr = __builtin_amdgcn_permlane32_swap(__float_as_uint(ps), __float_as_uint(ps), false, false);
    ps = __uint_as_float(rr[0]) + __uint_as_float(rr[1]); }
  l_reg = l_reg * alpha + ps;
#define PK4(P, BASE, OUT) do { unsigned a0 = cvtpk(P[BASE + 0], P[BASE + 1]), a1 = cvtpk(P[BASE + 2], P[BASE + 3]);   \
    unsigned b0 = cvtpk(P[BASE + 4], P[BASE + 5]), b1 = cvtpk(P[BASE + 6], P[BASE + 7]);                              \
    auto r0 = __builtin_amdgcn_permlane32_swap(a0, b0, false, false); auto r1 = __builtin_amdgcn_permlane32_swap(a1, b1, false, false); \
    u32x4 w = {r0[0], r1[0], r0[1], r1[1]}; OUT = *reinterpret_cast<bf16x8*>(&w); } while (0)
  PK4(p0, 0, pa0); PK4(p0, 8, pa1); PK4(p1, 0, pa2); PK4(p1, 8, pa3);
#undef PK4
}
__device__ __forceinline__ void qkt(f32x16& p0, f32x16& p1, const bf16* Ks, const bf16x8* qr, int r32, int hi) {
  p0 = f32x16{}; p1 = f32x16{};
  for (int d0 = 0; d0 < 8; ++d0) { int cb = (d0 * 16 + hi * 8) * 2;
    bf16x8 b0 = *reinterpret_cast<const bf16x8*>((const char*)Ks + KSWZ(r32, cb));
    bf16x8 b1 = *reinterpret_cast<const bf16x8*>((const char*)Ks + KSWZ(32 + r32, cb));
    p0 = __builtin_amdgcn_mfma_f32_32x32x16_bf16(b0, qr[d0], p0, 0, 0, 0);
    p1 = __builtin_amdgcn_mfma_f32_32x32x16_bf16(b1, qr[d0], p1, 0, 0, 0); }
}
__device__ __forceinline__ int v_st(int k, int c) { const int kk = (k & ~0xC) | ((k & 4) << 1) | ((k & 8) >> 1); return ((kk >> 3) * 4 + (c >> 5)) * 512 + ((kk & 7) * 32 + (c & 31)) * 2; }
__device__ __forceinline__ int v_rd_base(int lane) { return ((lane & 3) << 3) | (((lane >> 2) & 3) << 6) | (((lane >> 4) & 1) << 5) | (((lane >> 5) & 1) << 8); }
constexpr int v_rd_off(int d0, int ks, int half) { return d0 * 512 + ks * 4096 + half * 2048; }
template <int OFF> __device__ __forceinline__ s16x4 tr_read(int vb) {
  s16x4 r; asm volatile("ds_read_b64_tr_b16 %0, %1 offset:%2" : "=&v"(r) : "v"(vb), "i"(OFF) : "memory"); return r;
}
template <int D0> __device__ __forceinline__ void pv_one(f32x16& od, int vb, bf16x8 pa0, bf16x8 pa1, bf16x8 pa2, bf16x8 pa3) {
  const s16x4 l0 = tr_read<v_rd_off(D0, 0, 0)>(vb), h0 = tr_read<v_rd_off(D0, 0, 1)>(vb), l1 = tr_read<v_rd_off(D0, 1, 0)>(vb), h1 = tr_read<v_rd_off(D0, 1, 1)>(vb);
  const s16x4 l2 = tr_read<v_rd_off(D0, 2, 0)>(vb), h2 = tr_read<v_rd_off(D0, 2, 1)>(vb), l3 = tr_read<v_rd_off(D0, 3, 0)>(vb), h3 = tr_read<v_rd_off(D0, 3, 1)>(vb);
  asm volatile("s_waitcnt lgkmcnt(0)" ::: "memory"); SBAR();
#define PK(L, H) (bf16x8){L[0], L[1], L[2], L[3], H[0], H[1], H[2], H[3]}
  od = __builtin_amdgcn_mfma_f32_32x32x16_bf16(pa0, PK(l0, h0), od, 0, 0, 0);
  od = __builtin_amdgcn_mfma_f32_32x32x16_bf16(pa1, PK(l1, h1), od, 0, 0, 0);
  od = __builtin_amdgcn_mfma_f32_32x32x16_bf16(pa2, PK(l2, h2), od, 0, 0, 0);
  od = __builtin_amdgcn_mfma_f32_32x32x16_bf16(pa3, PK(l3, h3), od, 0, 0, 0);
#undef PK
}
__device__ __forceinline__ void pv_d0(f32x16* o, int vb, bf16x8 pa0, bf16x8 pa1, bf16x8 pa2, bf16x8 pa3) {
  pv_one<0>(o[0], vb, pa0, pa1, pa2, pa3); pv_one<1>(o[1], vb, pa0, pa1, pa2, pa3); pv_one<2>(o[2], vb, pa0, pa1, pa2, pa3); pv_one<3>(o[3], vb, pa0, pa1, pa2, pa3);
}

struct AttnJob {
  const bfu* Q; const bfu* K; const bfu* V;
  int NT, nctx, skip;
  int band, qpos0;
  int has_sink; float sink;
  const bfu* gate; bfu* outp;
};

__device__ __forceinline__ void attn_body(const AttnJob& J, char* lds) {
  int tid = threadIdx.x; asm volatile("" : "+v"(tid));
  const int wid = tid >> 6, lane = tid & 63, r32 = lane & 31, hi = lane >> 5;
  bf16* V_lds = (bf16*)lds; bf16* K_lds = (bf16*)(lds + 2 * SHM_V);
  float* wsm = (float*)(lds + 2 * SHM_V + 2 * SHM_K) + wid * 64; float* li_l = wsm; float* al_l = wsm + 32;
  float m_reg = -1e30f, l_reg = 0; f32x16 o[4] = {}; bf16x8 qr[8];
  const bfu* Qw = J.Q + (long)(wid * QBLK + r32) * 128 + hi * 8;
#pragma unroll
  for (int d0 = 0; d0 < 8; ++d0) qr[d0] = *reinterpret_cast<const bf16x8*>(Qw + d0 * 16);
  const int sr = tid >> 4, sc = (tid & 15) * 8, vst0 = v_st(sr, sc), vst1 = v_st(32 + sr, sc);
  const int vb0 = (int)(uintptr_t)V_lds + v_rd_base(lane);
  const bfu* Kh = J.K; const bfu* Vh = J.V;
  const int NT = J.NT, nctx = J.nctx, skip = J.skip;
  struct { bf16x8 vs0, vs1, ks0, ks1; } sr_[2];
#define KOFF(j) ((j) * KVBLK + ((j) >= nctx ? skip : 0))
#define SLOAD(i, k0) do { sr_[i].vs0 = *(const bf16x8*)(&Vh[(long)((k0) + sr) * 128 + sc]); sr_[i].vs1 = *(const bf16x8*)(&Vh[(long)((k0) + 32 + sr) * 128 + sc]); \
    sr_[i].ks0 = *(const bf16x8*)(&Kh[(long)((k0) + sr) * 128 + sc]); sr_[i].ks1 = *(const bf16x8*)(&Kh[(long)((k0) + 32 + sr) * 128 + sc]); } while (0)
#define SWRITE(b, i) do { *(bf16x8*)((char*)V_lds + (b) * SHM_V + vst0) = sr_[i].vs0;          \
    *(bf16x8*)((char*)V_lds + (b) * SHM_V + vst1) = sr_[i].vs1; int kc = sc * 2;               \
    *(bf16x8*)((char*)K_lds + (b) * SHM_K + KSWZ(sr, kc)) = sr_[i].ks0;                       \
    *(bf16x8*)((char*)K_lds + (b) * SHM_K + KSWZ(32 + sr, kc)) = sr_[i].ks1; } while (0)
#define SWAIT() asm volatile("s_waitcnt vmcnt(4)" ::: "memory")
#define RESC(a) do { if (__any((a) < 1.f)) { if (hi == 0) al_l[r32] = (a); asm volatile("s_waitcnt lgkmcnt(0)" ::: "memory"); \
    for (int d = 0; d < 4; ++d) for (int r = 0; r < 16; ++r) o[d][r] *= al_l[crow(r, hi)]; } } while (0)
#define MASK(P0, P1, j) do { if (J.band && (j) >= nctx) { const int kb = KOFF(j) - nctx * KVBLK, qw = J.qpos0 + wid * QBLK; \
    if (kb + 63 - qw > 128 || qw + 31 - kb > 128) { const int qp = qw + r32; \
      _Pragma("unroll") for (int r = 0; r < 16; ++r) { int d0_ = kb + crow(r, hi) - qp, d1_ = d0_ + 32; \
        if (d0_ > 128 || d0_ < -128) P0[r] = -1e30f; if (d1_ > 128 || d1_ < -128) P1[r] = -1e30f; } } } } while (0)
  f32x16 pA0, pA1, pB0, pB1; float mnA, mnB, alA, alB; bf16x8 pa0, pa1, pa2, pa3;
  constexpr int SE = 0, SO = 1;
  SLOAD(SE, KOFF(0)); asm volatile("s_waitcnt vmcnt(0)" ::: "memory"); SWRITE(0, SE); __syncthreads();
  qkt(pA0, pA1, K_lds, qr, r32, hi); MASK(pA0, pA1, 0); partialSM(pA0, pA1, m_reg, mnA, alA);
  SLOAD(SO, KOFF(1)); if (2 < NT) SLOAD(SE, KOFF(2));
  SWAIT(); SWRITE(1, SO); __syncthreads();
  for (int j = 1; j + 1 < NT; j += 2) {
    SBAR(); qkt(pB0, pB1, (bf16*)((char*)K_lds + SHM_K), qr, r32, hi);
    finishSM(pA0, pA1, alA, l_reg, pa0, pa1, pa2, pa3); SBAR();
    SLOAD(SO, KOFF(j + 2)); SBAR();
    pv_d0(o, vb0, pa0, pa1, pa2, pa3); MASK(pB0, pB1, j); partialSM(pB0, pB1, m_reg, mnB, alB);
    __syncthreads(); SWAIT(); SWRITE(0, SE);
    RESC(alB); __syncthreads();
    SBAR(); qkt(pA0, pA1, K_lds, qr, r32, hi);
    finishSM(pB0, pB1, alB, l_reg, pa0, pa1, pa2, pa3); SBAR();
    if (j + 3 < NT) SLOAD(SE, KOFF(j + 3)); SBAR();
    pv_d0(o, vb0 + (int)SHM_V, pa0, pa1, pa2, pa3); MASK(pA0, pA1, j + 1); partialSM(pA0, pA1, m_reg, mnA, alA);
    __syncthreads(); SWAIT(); SWRITE(1, SO);
    RESC(alA); __syncthreads();
  }
  SBAR(); qkt(pB0, pB1, (bf16*)((char*)K_lds + SHM_K), qr, r32, hi);
  finishSM(pA0, pA1, alA, l_reg, pa0, pa1, pa2, pa3); SBAR();
  pv_d0(o, vb0, pa0, pa1, pa2, pa3); MASK(pB0, pB1, NT - 1); partialSM(pB0, pB1, m_reg, mnB, alB);
  __syncthreads(); RESC(alB);
  finishSM(pB0, pB1, alB, l_reg, pa0, pa1, pa2, pa3); SBAR();
  pv_d0(o, vb0 + (int)SHM_V, pa0, pa1, pa2, pa3);
  if (J.has_sink) l_reg += __builtin_amdgcn_exp2f(J.sink * 1.4426950408889634f - m_reg * (SCALE * 1.4426950408889634f));
  if (hi == 0) li_l[r32] = l_reg; asm volatile("s_waitcnt lgkmcnt(0)" ::: "memory");
  float rli[16];
#pragma unroll
  for (int r = 0; r < 16; ++r) rli[r] = __builtin_amdgcn_rcpf(li_l[crow(r, hi)]);
  int t2 = threadIdx.x; asm volatile("" : "+v"(t2));
  const int wid2 = t2 >> 6, r32b = t2 & 31, hib = (t2 >> 5) & 1;
  bfu graw[16][4];
#pragma unroll
  for (int r = 0; r < 16; ++r) {
    const int orow = wid2 * QBLK + crow(r, hib);
#pragma unroll
    for (int d0 = 0; d0 < 4; ++d0) graw[r][d0] = J.gate[(size_t)orow * NU + d0 * 32 + r32b];
  }
#pragma unroll
  for (int r = 0; r < 16; ++r) {
    const int orow = wid2 * QBLK + crow(r, hib);
#pragma unroll
    for (int d0 = 0; d0 < 4; ++d0) {
      const float g = bf2f(graw[r][d0]);
      J.outp[(size_t)orow * 4096 + d0 * 32 + r32b] = f2bf(o[d0][r] * rli[r] * silu(g));
    }
  }
#undef SLOAD
#undef SWRITE
#undef SWAIT
#undef RESC
#undef MASK
#undef KOFF
  __syncthreads();
}

__device__ __forceinline__ void attn_job(const Params& p, int l, int a, char* lds) {
  AttnJob J;
  const int grp = a >> 7, i = a & 127;
  if (grp < 2) {
    const int type = grp == 0 ? 3 : 2, b = i >> 6, h = (i >> 3) & 7, qb = i & 7, q0 = qb * 256;
    const size_t kvoff = type == 2 ? 2097152 : 3407872;
    J.Q = p.Qb + (size_t)type * 4194304 + ((size_t)(b * 8 + h) * 2048 + q0) * 128;
    J.K = p.Kb + kvoff + (size_t)(b * 2 + (h >> 2)) * 2560 * 128; J.V = p.Vb + kvoff + (size_t)(b * 2 + (h >> 2)) * 2560 * 128;
    const int row0 = 4096 + b * 2048 + q0;
    if (type == 3) { J.NT = 40; J.nctx = 40; J.skip = 0; J.band = 0; J.qpos0 = 0; J.has_sink = 0; J.sink = 0.f;
      J.gate = p.u + (size_t)row0 * NU + C_GLBG + h * 128; J.outp = p.merged + (size_t)row0 * 4096 + 3072 + h * 128; }
    else { const int lo = max(0, q0 - 128), hiK = min(2048, q0 + 384);
      J.NT = 8 + (hiK - lo) / 64; J.nctx = 8; J.skip = lo; J.band = 1; J.qpos0 = q0; J.has_sink = 1; J.sink = p.swa_sink[l * 8 + h];
      J.gate = p.u + (size_t)row0 * NU + C_SWAG + h * 128; J.outp = p.merged + (size_t)row0 * 4096 + 2048 + h * 128; }
  } else {
    const int type = grp == 2 ? 0 : 1, b = i >> 3, h = i & 7;
    const size_t kvoff = type == 0 ? 0 : 1048576;
    J.Q = p.Qb + (size_t)type * 4194304 + (size_t)(b * 8 + h) * 256 * 128;
    J.K = p.Kb + kvoff + (size_t)(b * 2 + (h >> 2)) * 256 * 128; J.V = p.Vb + kvoff + (size_t)(b * 2 + (h >> 2)) * 256 * 128;
    const int row0 = b * 256;
    J.NT = 4; J.nctx = 4; J.skip = 0; J.band = 0; J.qpos0 = 0;
    if (type == 0) { J.has_sink = 1; J.sink = p.swa_sink[l * 8 + h];
      J.gate = p.u + (size_t)row0 * NU + C_SWAG + h * 128; J.outp = p.merged + (size_t)row0 * 4096 + 2048 + h * 128; }
    else { J.has_sink = 0; J.sink = 0.f;
      J.gate = p.u + (size_t)row0 * NU + C_GLBG + h * 128; J.outp = p.merged + (size_t)row0 * 4096 + 3072 + h * 128; }
  }
  attn_body(J, lds);
}

constexpr int M2_ATT = 512, M2_GLA = 1024, M2_LRU = 1024, M2_JOBS = M2_ATT + M2_GLA + M2_LRU;
__device__ __forceinline__ void phase_m2(const Params& p, int l, char* lds) {
  for (int bb = blockIdx.x; bb < 256; bb += gridDim.x) {
    const int natt = bb < 128 ? 1 : 3;
    for (int k = 0; k < natt; ++k) attn_job(p, l, k == 0 ? bb : 256 + (bb - 128) * 2 + (k - 1), lds);
    for (int k = 0; k < 4; ++k) { const int j = bb + 256 * k; gla_m2(p, l, j >> 3, j & 7, lds); }
  }
  int* jobslot = (int*)(lds + SHM_BYTES + 64);
  __syncthreads();
  if (threadIdx.x == 0) jobslot[0] = (int)atomicAdd(p.ctr + l, 1u);
  __syncthreads();
  int cur = __builtin_amdgcn_readfirstlane(jobslot[0]);
  while (cur < 1024) {
    __syncthreads();
    int nxt = 0;
    if (threadIdx.x == 0) nxt = (int)atomicAdd(p.ctr + l, 1u);
    lru_m2(p, l, ((cur >> 3) + 64) & 127, cur & 7);
    if (threadIdx.x == 0) jobslot[0] = nxt;
    __syncthreads();
    cur = __builtin_amdgcn_readfirstlane(jobslot[0]);
  }
}

#define XB_TMO      128
#define XB_XCNT(j)  (256  + 64 * (j))
#define XB_XSUB(j)  (1280 + 64 * (j))
#define XB_XGEN(j)  (2304 + 64 * (j))
#define XB_TOP      3328
#define XB_TOPGEN   3392
#define XCD_BAR_WORDS 3456
#define XB_SPIN_CAP (1u << 18)
#define LAS __attribute__((address_space(3)))
__device__ __forceinline__ unsigned xb_ld(unsigned* p)              { return __hip_atomic_load(p, __ATOMIC_RELAXED, __HIP_MEMORY_SCOPE_AGENT); }
__device__ __forceinline__ unsigned xb_add(unsigned* p, unsigned v) { return __hip_atomic_fetch_add(p, v, __ATOMIC_RELAXED, __HIP_MEMORY_SCOPE_AGENT); }
__device__ __forceinline__ unsigned xb_xcc_id() { return (unsigned)__builtin_amdgcn_s_getreg((3 << 11) | 20) & 0xFu; }
#define XB_SPIN(cond, bar) do { unsigned _sp = 0; while (cond) { __builtin_amdgcn_s_sleep(1); \
    if ((++_sp & 255u) == 0u) { if (xb_ld(&(bar)[XB_TMO])) break; if (_sp > XB_SPIN_CAP) { atomicAdd(&(bar)[XB_TMO], 1u); break; } } } } while (0)
struct XcdBarrier { unsigned* bar; unsigned x; volatile LAS unsigned* st; };
__device__ __forceinline__ XcdBarrier xcd_barrier_post(unsigned* bar, volatile LAS unsigned* st) {
  XcdBarrier b; b.bar = bar; b.x = xb_xcc_id(); b.st = st;
  if (threadIdx.x == 0) (void)xb_add(&bar[XB_XCNT(b.x)], 1u);
  return b;
}
__device__ __forceinline__ void xcd_barrier_complete(unsigned* bar, unsigned x, unsigned& nloc, unsigned& nx) {
  const unsigned G = gridDim.x * gridDim.y * gridDim.z;
  unsigned sum, cnt, mine, sp = 0u;
  for (;;) {
    sum = 0u; cnt = 0u; mine = 0u;
#pragma unroll
    for (unsigned j = 0; j < 16; ++j) { const unsigned c = xb_ld(&bar[XB_XCNT(j)]); sum += c; cnt += (c > 0u) ? 1u : 0u; mine = (j == x) ? c : mine; }
    if (sum == G) break;
    __builtin_amdgcn_s_sleep(1);
    if ((++sp & 255u) == 0u) { if (xb_ld(&bar[XB_TMO])) break; if (sp > XB_SPIN_CAP) { atomicAdd(&bar[XB_TMO], 1u); break; } }
  }
  nloc = mine > 0u ? mine : 1u; nx = cnt > 0u ? cnt : 1u;
}
__device__ __forceinline__ void xcd_barrier(const XcdBarrier& b) {
  asm volatile("s_waitcnt vmcnt(0)" ::: "memory");
  __syncthreads();
  if (threadIdx.x == 0) {
    unsigned* bar = b.bar;
    __builtin_amdgcn_s_waitcnt(0);
    unsigned nloc = b.st[0], nx = b.st[1];
    if (nloc == 0u) { xcd_barrier_complete(bar, b.x, nloc, nx); b.st[0] = nloc; b.st[1] = nx; }
    const unsigned old = xb_add(&bar[XB_XSUB(b.x)], 1u);
    const unsigned gen = old / nloc;
    if (old + 1u == (gen + 1u) * nloc) {
      __builtin_amdgcn_fence(__ATOMIC_RELEASE, "agent");
      asm volatile("s_waitcnt vmcnt(0)" ::: "memory");
      const unsigned og = xb_add(&bar[XB_TOP], 1u);
      const unsigned tg = og / nx;
      if (og + 1u == (tg + 1u) * nx) xb_add(&bar[XB_TOPGEN], 1u);
      else XB_SPIN(xb_ld(&bar[XB_TOPGEN]) == tg, bar);
      __builtin_amdgcn_fence(__ATOMIC_ACQUIRE, "agent");
      xb_add(&bar[XB_XGEN(b.x)], 1u);
      asm volatile("s_waitcnt vmcnt(0)" ::: "memory");
    } else {
      XB_SPIN(xb_ld(&bar[XB_XGEN(b.x)]) == gen, bar);
      __builtin_amdgcn_fence(__ATOMIC_ACQUIRE, "agent");
      asm volatile("s_waitcnt vmcnt(0)" ::: "memory");
    }
  }
  __syncthreads();
}

#if MULTI_LAUNCH
__global__ void __launch_bounds__(512, 2) phase_kernel(Params p, int ph) {
  char* lds = (char*)shm;
  switch (ph) {
    case 0: phase0(p, lds); break;
    case 1: phase_norm(p, 0, lds); break;
    case 2: phase_gemm_in(p, 0, lds); break;
    case 3: phase_m1(p, 0, lds); break;
    case 4: phase_m2(p, 0, lds); break;
    case 5: phase_gemm_out(p, 0); break;
    case 6: phase_norm(p, 1, lds); break;
    case 7: phase_gemm_in(p, 1, lds); break;
    case 8: phase_m1(p, 1, lds); break;
    case 9: phase_m2(p, 1, lds); break;
    case 10: phase_gemm_out(p, 1); break;
    case 11: phase_norm(p, 2, lds); break;
  }
}
#else
__global__ void __launch_bounds__(512, 2) mega_kernel(Params p) {
  cg::grid_group grid = cg::this_grid();
  char* lds = (char*)shm;
  volatile LAS unsigned* st = (volatile LAS unsigned*)((LAS char*)shm + SHM_BYTES);
  if (threadIdx.x == 0) { st[0] = 0u; st[1] = 0u; }
  XcdBarrier xb = xcd_barrier_post(p.bar, st);
  if (p.never) grid.sync();
  phase0(p, lds); xcd_barrier(xb);
  phase_norm(p, 0, lds); xcd_barrier(xb);
  phase_gemm_in(p, 0, lds); xcd_barrier(xb);
  phase_m1(p, 0, lds); xcd_barrier(xb);
  phase_m2(p, 0, lds); xcd_barrier(xb);
  phase_gemm_out(p, 0); xcd_barrier(xb);
  phase_norm(p, 1, lds); xcd_barrier(xb);
  phase_gemm_in(p, 1, lds); xcd_barrier(xb);
  phase_m1(p, 1, lds); xcd_barrier(xb);
  phase_m2(p, 1, lds); xcd_barrier(xb);
  phase_gemm_out(p, 1); xcd_barrier(xb);
  phase_norm(p, 2, lds);
}
#endif

static size_t al256(size_t x) { return (x + 255) / 256 * 256; }

extern "C" void kernel_launch(void* const* d_in, const int* in_sizes, int n_in, void* d_out, int out_size, void* d_ws, size_t ws_size,
                              hipStream_t stream) {
  Params p{};
  const float** pf = (const float**)&p;
  for (int i = 0; i < 29; ++i) pf[i] = (const float*)d_in[i];
  p.out = (float*)d_out;
  char* w = (char*)d_ws; size_t off = 0;
  auto take = [&](size_t bytes) { char* r = w + off; off = al256(off + bytes); return r; };
  p.WinT = (bfu*)take((size_t)2 * NG * 4096 * 2);
  p.WlrT = (bfu*)take((size_t)2 * 32 * 4096 * 2);
  p.WoutT = (bfu*)take((size_t)2 * 4096 * 4096 * 2);
  p.WgT = (bfu*)take((size_t)64 * 16384 * 2);
  p.hbuf = (bfu*)take((size_t)NTOK * 4096 * 2);
  p.u = (bfu*)take((size_t)NTOK * NU * 2);
  p.merged = (bfu*)take((size_t)NTOK * 4096 * 2);
  p.Qb = (bfu*)take((size_t)4 * 4194304 * 2);
  p.Kb = (bfu*)take((size_t)4718592 * 2);
  p.Vb = (bfu*)take((size_t)4718592 * 2);
  p.modv = (float*)take((size_t)6 * 12288 * 4);
  p.rope = (float*)take((size_t)2048 * 128 * 4);
  p.xbuf = (bfu*)take((size_t)NTOK * 4096 * 2);
  p.scan = (bfu*)take((size_t)4 * 8388608 * 2);
  p.lsum = (float*)take((size_t)2 * 128 * 1024 * 2 * 4);
  p.kv = (float*)take((size_t)128 * 8 * 2 * 8192 * 4);
  p.dec = (float*)take((size_t)128 * 8 * 2 * 64 * 4);
  p.sp8 = (float*)take((size_t)4096 * 4);
  p.ctr = (unsigned*)take(256);
  p.bar = (unsigned*)take((size_t)XCD_BAR_WORDS * 4);
  if (off > ws_size || n_in != 29) { fprintf(stderr, "kernel_launch: ws too small (%zu > %zu) or n_in %d\n", off, ws_size, n_in); return; }
#if MULTI_LAUNCH
  static int init = 0;
  if (!init) { hipFuncSetAttribute((const void*)phase_kernel, hipFuncAttributeMaxDynamicSharedMemorySize, SHM_BYTES); init = 1; }
  for (int ph = 0; ph < 12; ++ph) hipLaunchKernelGGL(phase_kernel, dim3(256), dim3(512), SHM_BYTES, stream, p, ph);
#else
  static int grid_blocks = 0;
  if (!grid_blocks) {
    hipFuncSetAttribute((const void*)mega_kernel, hipFuncAttributeMaxDynamicSharedMemorySize, SHM_TOTAL);
    int dev = 0, cus = 0, per_cu = 0;
    hipGetDevice(&dev);
    hipDeviceGetAttribute(&cus, hipDeviceAttributeMultiprocessorCount, dev);
    hipOccupancyMaxActiveBlocksPerMultiprocessor(&per_cu, mega_kernel, 512, SHM_TOTAL);
    if (per_cu > 1) per_cu = 1;
    grid_blocks = cus * per_cu;
    if (grid_blocks <= 0) { fprintf(stderr, "occupancy query failed\n"); grid_blocks = 0; return; }
  }
  void* args[] = {&p};
  (void)hipMemsetAsync(p.bar, 0, (size_t)XCD_BAR_WORDS * 4, stream);
  hipError_t e = hipLaunchCooperativeKernel((void*)mega_kernel, dim3(grid_blocks), dim3(512), args, SHM_TOTAL, stream);
  if (e != hipSuccess) fprintf(stderr, "cooperative launch failed: %s (grid %d)\n", hipGetErrorString(e), grid_blocks);
#endif
}
```
